# Optimizing an MI355X kernel written in HIP

```python
import jax, jax.numpy as jnp
from jax import lax
import numpy as np

D_MODEL = 1024
BATCH = 32
SEQ = 2048
DEPTH = 1

CHUNK = 64
N_META = 16
META_PAD = CHUNK - N_META
D_MIX = D_MODEL
GLA_HEADS = 4
GLA_VAL = D_MIX // 2
GLA_DV = GLA_VAL // GLA_HEADS
GLA_KEY = GLA_VAL // 2
GLA_DK = GLA_KEY // GLA_HEADS
GLA_GATE_RANK = 16
GLA_TAU = 16.0
SSD_INNER = D_MIX - GLA_VAL
SSD_HEADDIM = 64
SSD_HEADS = SSD_INNER // SSD_HEADDIM
SSD_GROUPS = 2
SSD_HEADS_PER_GROUP = SSD_HEADS // SSD_GROUPS
SSD_STATE = 128
SSD_CONV = 4
SSD_CONV_CH = SSD_INNER + 2 * SSD_GROUPS * SSD_STATE
IN_SPLITS = (GLA_KEY, GLA_KEY, GLA_VAL, GLA_VAL, GLA_GATE_RANK, SSD_INNER, SSD_CONV_CH, SSD_HEADS)
D_IN_PROJ = sum(IN_SPLITS)
N_EXPERTS = 32
TOP_K = 4
D_FF = D_MODEL
SWIGLU_LIMIT = 7.0
SWIGLU_ALPHA = 1.702
MOE_BLOCK = 256
DEEPNORM_ALPHA = (2.0 * DEPTH) ** 0.25
DEEPNORM_BETA = (8.0 * DEPTH) ** -0.25
LN_EPS = 1e-5
RMS_EPS = 1e-6

kernel_name = "hymba_gla_ssd_deepnorm_moe"


def layer_norm(t, g, b):
    tf = t.astype(jnp.float32)
    mu = jnp.mean(tf, axis=-1, keepdims=True)
    var = jnp.mean(jnp.square(tf - mu), axis=-1, keepdims=True)
    return ((tf - mu) * lax.rsqrt(var + LN_EPS) * g + b).astype(t.dtype)


def rms_norm(t, g):
    tf = t.astype(jnp.float32)
    return tf * lax.rsqrt(jnp.mean(jnp.square(tf), axis=-1, keepdims=True) + RMS_EPS) * g


def split_last(t, sizes):
    idx = [int(i) for i in np.cumsum(sizes)[:-1]]
    return jnp.split(t, idx, axis=-1)


def causal_depthwise_conv(u, w, b):
    out = lax.conv_general_dilated(
        u, w[:, None, :].astype(u.dtype), window_strides=(1,), padding=[(SSD_CONV - 1, 0)],
        dimension_numbers=("NWC", "WIO", "NWC"), feature_group_count=u.shape[-1])
    return out + b


def gla_chunk_causal(q, k, v, log_a):
    b, lp, _ = q.shape
    nc = lp // CHUNK
    qc = q.reshape(b, nc, CHUNK, GLA_HEADS, GLA_DK).astype(jnp.float32)
    kc = k.reshape(b, nc, CHUNK, GLA_HEADS, GLA_DK).astype(jnp.float32)
    vc = v.reshape(b, nc, CHUNK, GLA_HEADS, GLA_DV).astype(jnp.float32)
    cum = jnp.cumsum(log_a.reshape(b, nc, CHUNK, GLA_HEADS, GLA_DK), axis=2)
    total = cum[:, :, -1]
    k_dec = kc * jnp.exp(total[:, :, None] - cum)
    u = jnp.einsum("bcqhk,bcqhv->bchkv", k_dec, vc)

    def step(s, inp):
        dec, uc = inp
        s = dec[..., None] * s + uc
        return s, s

    _, states = lax.scan(step, jnp.zeros_like(u[:, 0]),
                         (jnp.moveaxis(jnp.exp(total), 1, 0), jnp.moveaxis(u, 1, 0)))
    states = jnp.moveaxis(states, 0, 1)
    o = jnp.einsum("bcqhk,bchkv->bcqhv", qc, states)
    return o.reshape(b, lp, GLA_VAL)


def ssd_chunk_causal(xs, dt, a, bm, cm):
    b, lp, _ = xs.shape
    nc = lp // CHUNK
    g, hg = SSD_GROUPS, SSD_HEADS_PER_GROUP
    xh = xs.reshape(b, nc, CHUNK, g, hg, SSD_HEADDIM).astype(jnp.float32)
    dtc = dt.reshape(b, nc, CHUNK, g, hg)
    bc = bm.reshape(b, nc, CHUNK, g, SSD_STATE).astype(jnp.float32)
    cc = cm.reshape(b, nc, CHUNK, g, SSD_STATE).astype(jnp.float32)
    cum = jnp.cumsum(dtc * a.reshape(g, hg), axis=2)
    total = cum[:, :, -1]
    w = jnp.exp(total[:, :, None] - cum) * dtc
    u = jnp.einsum("bcqgn,bcqgh,bcqghp->bcghnp", bc, w, xh)

    def step(s, inp):
        dec, uc = inp
        s = dec[..., None, None] * s + uc
        return s, s

    _, states = lax.scan(step, jnp.zeros_like(u[:, 0]),
                         (jnp.moveaxis(jnp.exp(total), 1, 0), jnp.moveaxis(u, 1, 0)))
    states = jnp.moveaxis(states, 0, 1)
    y = jnp.einsum("bcqgn,bcghnp->bcqghp", cc, states)
    return y.reshape(b, lp, SSD_INNER)


def hybrid_mixer(h, w_in, gla_w_a2, gla_b_a, gla_norm_g, ssd_conv_w, ssd_conv_b,
                 ssd_dt_bias, ssd_a_log, ssd_d, ssd_norm_g, w_out):
    b, l, _ = h.shape
    proj = h @ w_in
    proj = jnp.pad(proj, ((0, 0), (META_PAD, 0), (0, 0)))
    lp = l + META_PAD
    valid = (jnp.arange(lp) >= META_PAD)[None, :, None]
    q, k, v, og, a1, z, xbc, dt_raw = split_last(proj, IN_SPLITS)

    log_a = jax.nn.log_sigmoid((a1 @ gla_w_a2 + gla_b_a).astype(jnp.float32)) / GLA_TAU
    log_a = jnp.where(valid, log_a, 0.0)
    o_gla = gla_chunk_causal(q * (GLA_DK ** -0.5), k, v, log_a)[:, META_PAD:]
    o_gla = rms_norm(o_gla.reshape(b, l, GLA_HEADS, GLA_DV), gla_norm_g.reshape(GLA_HEADS, GLA_DV))
    o_gla = o_gla.reshape(b, l, GLA_VAL) * jax.nn.silu(og[:, META_PAD:].astype(jnp.float32))

    xbc = jax.nn.silu(causal_depthwise_conv(xbc, ssd_conv_w, ssd_conv_b))
    xs, bm, cm = split_last(xbc, (SSD_INNER, SSD_GROUPS * SSD_STATE, SSD_GROUPS * SSD_STATE))
    dt = jax.nn.softplus(dt_raw.astype(jnp.float32) + ssd_dt_bias)
    dt = jnp.where(valid, dt, 0.0)
    a = -jnp.exp(ssd_a_log.astype(jnp.float32))
    y = ssd_chunk_causal(xs, dt, a, bm, cm)
    y = y + (xs.reshape(b, lp, SSD_HEADS, SSD_HEADDIM) * ssd_d[:, None]).reshape(b, lp, SSD_INNER)
    y = y[:, META_PAD:] * jax.nn.silu(z[:, META_PAD:].astype(jnp.float32))
    gsz = SSD_INNER // SSD_GROUPS
    y = rms_norm(y.reshape(b, l, SSD_GROUPS, gsz), ssd_norm_g.reshape(SSD_GROUPS, gsz))
    y = y.reshape(b, l, SSD_INNER)

    mix = jnp.concatenate([o_gla, y], axis=-1).astype(h.dtype)
    return mix @ w_out


def clamped_swiglu(a, u):
    a = jnp.minimum(a, SWIGLU_LIMIT)
    u = jnp.clip(u, -SWIGLU_LIMIT, SWIGLU_LIMIT)
    return a * jax.nn.sigmoid(SWIGLU_ALPHA * a) * (u + 1.0)


def moe_ffn(t, router_w, router_b, w_gate, w_up, b_gate, b_up, w_down, b_down):
    n, d = t.shape
    logits = (t @ router_w + router_b).astype(jnp.float32)
    top_v, top_i = lax.top_k(logits, TOP_K)
    gates = jax.nn.softmax(top_v, axis=-1)
    flat_e = top_i.reshape(-1)
    flat_tok = jnp.arange(n * TOP_K, dtype=jnp.int32) // TOP_K
    flat_g = gates.reshape(-1)
    order = jnp.argsort(flat_e)
    sorted_e = flat_e[order]
    counts = jnp.zeros((N_EXPERTS,), jnp.int32).at[flat_e].add(1)
    starts = jnp.cumsum(counts) - counts
    padded = (counts + MOE_BLOCK - 1) // MOE_BLOCK * MOE_BLOCK
    pad_end = jnp.cumsum(padded)
    pad_start = pad_end - padded
    dest = pad_start[sorted_e] + (jnp.arange(n * TOP_K, dtype=jnp.int32) - starts[sorted_e])
    n_blocks = -(-(n * TOP_K) // MOE_BLOCK) + N_EXPERTS
    rows = n_blocks * MOE_BLOCK
    row_tok = jnp.full((rows,), n, jnp.int32).at[dest].set(flat_tok[order])
    row_gate = jnp.zeros((rows,), jnp.float32).at[dest].set(flat_g[order])
    block_e = jnp.minimum(
        jnp.searchsorted(pad_end, jnp.arange(n_blocks, dtype=jnp.int32) * MOE_BLOCK, side="right"),
        N_EXPERTS - 1)
    t_pad = jnp.concatenate([t, jnp.zeros((1, d), t.dtype)], axis=0)

    def expert_block(inp):
        tok, gt, e = inp
        xb = t_pad[tok]
        hid = clamped_swiglu(xb @ w_gate[e] + b_gate[e], xb @ w_up[e] + b_up[e])
        yb = hid @ w_down[e] + b_down[e]
        return (yb * gt[:, None].astype(yb.dtype)).astype(t.dtype)

    yb = lax.map(expert_block, (row_tok.reshape(n_blocks, MOE_BLOCK),
                                row_gate.reshape(n_blocks, MOE_BLOCK), block_e))
    out = jax.ops.segment_sum(yb.reshape(rows, d), row_tok, num_segments=n + 1)
    return out[:n]


def setup_inputs(seed: int = 0) -> dict:
    key = jax.random.key(seed)
    ks = jax.random.split(key, 32)
    f32 = jnp.float32

    def nrm(k, shape, scale):
        return jax.random.normal(k, shape, f32) * scale

    dt0 = jnp.exp(jax.random.uniform(ks[10], (DEPTH, SSD_HEADS), f32, np.log(1e-3), np.log(1e-1)))
    return {
        "x": nrm(ks[0], (BATCH, SEQ, D_MODEL), 1.0),
        "meta_tokens": nrm(ks[1], (N_META, D_MODEL), 1.0),
        "ln_in_g": 1.0 + nrm(ks[2], (D_MODEL,), 0.02),
        "ln_in_b": nrm(ks[3], (D_MODEL,), 0.02),
        "w_in": nrm(ks[4], (DEPTH, D_MODEL, D_IN_PROJ), D_MODEL ** -0.5),
        "gla_w_a2": nrm(ks[5], (DEPTH, GLA_GATE_RANK, GLA_KEY), GLA_GATE_RANK ** -0.5),
        "gla_b_a": nrm(ks[6], (DEPTH, GLA_KEY), 0.1),
        "gla_norm_g": 1.0 + nrm(ks[7], (DEPTH, GLA_VAL), 0.02),
        "ssd_conv_w": nrm(ks[8], (DEPTH, SSD_CONV, SSD_CONV_CH), SSD_CONV ** -0.5),
        "ssd_conv_b": nrm(ks[9], (DEPTH, SSD_CONV_CH), 0.02),
        "ssd_dt_bias": dt0 + jnp.log(-jnp.expm1(-dt0)),
        "ssd_a_log": jnp.log(jax.random.uniform(ks[11], (DEPTH, SSD_HEADS), f32, 1.0, 16.0)),
        "ssd_d": 1.0 + nrm(ks[12], (DEPTH, SSD_HEADS), 0.1),
        "ssd_norm_g": 1.0 + nrm(ks[13], (DEPTH, SSD_INNER), 0.02),
        "w_out": nrm(ks[14], (DEPTH, D_MIX, D_MODEL), D_MIX ** -0.5 * DEEPNORM_BETA),
        "ln1_g": 1.0 + nrm(ks[15], (DEPTH, D_MODEL), 0.02),
        "ln1_b": nrm(ks[16], (DEPTH, D_MODEL), 0.02),
        "router_w": nrm(ks[17], (DEPTH, D_MODEL, N_EXPERTS), D_MODEL ** -0.5),
        "router_b": nrm(ks[18], (DEPTH, N_EXPERTS), 0.01),
        "moe_w_gate": nrm(ks[19], (DEPTH, N_EXPERTS, D_MODEL, D_FF), D_MODEL ** -0.5),
        "moe_w_up": nrm(ks[20], (DEPTH, N_EXPERTS, D_MODEL, D_FF), D_MODEL ** -0.5),
        "moe_b_gate": nrm(ks[21], (DEPTH, N_EXPERTS, D_FF), 0.02),
        "moe_b_up": nrm(ks[22], (DEPTH, N_EXPERTS, D_FF), 0.02),
        "moe_w_down": nrm(ks[23], (DEPTH, N_EXPERTS, D_FF, D_MODEL), D_FF ** -0.5 * DEEPNORM_BETA),
        "moe_b_down": nrm(ks[24], (DEPTH, N_EXPERTS, D_MODEL), 0.02 * DEEPNORM_BETA),
        "ln2_g": 1.0 + nrm(ks[25], (DEPTH, D_MODEL), 0.02),
        "ln2_b": nrm(ks[26], (DEPTH, D_MODEL), 0.02),
    }


def reference(x, meta_tokens, ln_in_g, ln_in_b, w_in, gla_w_a2, gla_b_a, gla_norm_g,
              ssd_conv_w, ssd_conv_b, ssd_dt_bias, ssd_a_log, ssd_d, ssd_norm_g, w_out,
              ln1_g, ln1_b, router_w, router_b, moe_w_gate, moe_w_up, moe_b_gate, moe_b_up,
              moe_w_down, moe_b_down, ln2_g, ln2_b):
    b = x.shape[0]
    meta = jnp.broadcast_to(meta_tokens[None].astype(x.dtype), (b, N_META, D_MODEL))
    h = jnp.concatenate([meta, x], axis=1)
    h = layer_norm(h, ln_in_g, ln_in_b)
    for l in range(DEPTH):
        mix = hybrid_mixer(h, w_in[l], gla_w_a2[l], gla_b_a[l], gla_norm_g[l], ssd_conv_w[l],
                           ssd_conv_b[l], ssd_dt_bias[l], ssd_a_log[l], ssd_d[l], ssd_norm_g[l],
                           w_out[l])
        h = layer_norm(DEEPNORM_ALPHA * h + mix, ln1_g[l], ln1_b[l])
        ff = moe_ffn(h.reshape(-1, D_MODEL), router_w[l], router_b[l], moe_w_gate[l], moe_w_up[l],
                     moe_b_gate[l], moe_b_up[l], moe_w_down[l], moe_b_down[l]).reshape(h.shape)
        h = layer_norm(DEEPNORM_ALPHA * h + ff, ln2_g[l], ln2_b[l])
    return h[:, N_META:]
```

```cpp
#include <hip/hip_runtime.h>
#include <cstdio>
#include <cstdint>

#define LAS __attribute__((address_space(3)))
typedef unsigned short bf16_t;
typedef short bf16x8 __attribute__((ext_vector_type(8)));
typedef float f32x4 __attribute__((ext_vector_type(4)));
typedef float f32x16 __attribute__((ext_vector_type(16)));
typedef unsigned u32x4 __attribute__((ext_vector_type(4)));
typedef unsigned u32x2 __attribute__((ext_vector_type(2)));

constexpr int D = 1024, NB = 32, SEQ = 2048, NTOK = NB * SEQ, NMETA = 16;
constexpr int NCH = 33, LP = 2112;
constexpr int NPROJ = 3096, LDP = 3328;
constexpr int C_XBC = 0, C_Q = 1024, C_K = 1280, C_V = 1536, C_OG = 2048, C_Z = 2560, C_A1 = 3072, C_DT = 3088;
__host__ __device__ constexpr int proj_col(int n) { return n < 256 ? C_Q + n : n < 512 ? C_K + (n - 256) : n < 1024 ? C_V + (n - 512) : n < 1536 ? C_OG + (n - 1024) : n < 1552 ? C_A1 + (n - 1536) : n < 2064 ? C_Z + (n - 1552) : n < 3088 ? C_XBC + (n - 2064) : C_DT + (n - 3088); }
constexpr int NE = 32;
constexpr float ALPHA = 1.18920711500272f;
constexpr float LN_EPS = 1e-5f, RMS_EPS = 1e-6f;
constexpr int HROWS = NTOK + 256;
constexpr int NTHREADS = 512, NWAVES = 8;

constexpr size_t MiB = 1u << 20;
constexpr size_t WS_CTL = 0, CTL_BYTES = 1 * MiB;
constexpr size_t WS_WIN = 1 * MiB, WS_WOUT = 8 * MiB, WS_TLIST = 138 * MiB, WS_TOKSLOT = 146 * MiB, WS_TOKGATE = 147 * MiB;
constexpr size_t WS_Y = 148 * MiB, WS_HID = 676 * MiB, WS_H1Q = 940 * MiB;
constexpr size_t WS_H = 148 * MiB, WS_PROJ = 277 * MiB, WS_MIX = 706 * MiB, WS_V1 = 10 * MiB;
constexpr int HID_CAP_BLOCKS = NTOK * 4 / 256 + NE;
constexpr int W8_PITCH = D + 128;
constexpr size_t OUT_WGU = 0, OUT_WD = 80 * MiB;
static_assert((size_t)NE * 2048 * W8_PITCH <= OUT_WD && OUT_WD + (size_t)NE * D * W8_PITCH <= 256 * MiB, "expert weight copies fit in d_out");
constexpr float WD6_SCALE = 128.0f;
constexpr float H6_SCALE = 2.0f;
constexpr float W8_SCALE = 64.0f, HID8_SCALE = 8.0f, Y8_SCALE = 32.0f;
static_assert(WS_H + (size_t)HROWS * D * 2 <= WS_PROJ && WS_PROJ + (size_t)NB * LP * LDP * 2 <= WS_MIX && WS_MIX + (size_t)NTOK * D * 2 <= WS_H1Q, "ws map");
static_assert(WS_HID + (size_t)HID_CAP_BLOCKS * 256 * D <= WS_H1Q && WS_H1Q + (size_t)NTOK * D <= 1024 * MiB && WS_Y + (size_t)(NTOK * 4 + NE * 256) * D * 2 <= WS_HID, "ws map 2");
constexpr int LDS_BYTES = 163840;

__device__ __forceinline__ float bf2f(unsigned b) { return __uint_as_float(b << 16); }
typedef __bf16 bf16x2_t __attribute__((ext_vector_type(2)));
typedef float f32x2_t __attribute__((ext_vector_type(2)));
typedef short s16x4 __attribute__((ext_vector_type(4)));
typedef __bf16 bf16x32_t __attribute__((ext_vector_type(32)));
typedef unsigned u32x16 __attribute__((ext_vector_type(16)));
typedef unsigned u32x6 __attribute__((ext_vector_type(6)));
__device__ __forceinline__ u32x6 cvt_fp6x32(u32x16 v) { return __builtin_bit_cast(u32x6, __builtin_amdgcn_cvt_scalef32_pk32_fp6_bf16(__builtin_bit_cast(bf16x32_t, v), 1.0f)); }
__device__ __forceinline__ void store_fp6_block(unsigned char* slot, int g, u32x6 r) {
    *(u32x4*)(slot + 16 * g) = (u32x4){r[0], r[1], r[2], r[3]}; *(u32x2*)(slot + 64 + 8 * g) = (u32x2){r[4], r[5]}; }
__device__ __forceinline__ unsigned cvt_pk_bf16(float lo, float hi) { const f32x2_t f = {lo, hi}; return __builtin_bit_cast(unsigned, __builtin_convertvector(f, bf16x2_t)); }
__device__ __forceinline__ float clamp448(float x) { return fminf(fmaxf(x, -448.f), 448.f); }
__device__ __forceinline__ unsigned cvt_fp8x4_nc(float a, float b, float c, float d) {
    unsigned w = 0; w = __builtin_amdgcn_cvt_pk_fp8_f32(a, b, w, false); w = __builtin_amdgcn_cvt_pk_fp8_f32(c, d, w, true); return w; }
__device__ __forceinline__ unsigned cvt_fp8x4(float a, float b, float c, float d) {
    unsigned w = 0; w = __builtin_amdgcn_cvt_pk_fp8_f32(clamp448(a), clamp448(b), w, false); w = __builtin_amdgcn_cvt_pk_fp8_f32(clamp448(c), clamp448(d), w, true); return w; }
__device__ __forceinline__ bf16_t f2bf(float f) { return (bf16_t)(cvt_pk_bf16(f, 0.f) & 0xffffu); }
__device__ __forceinline__ float wave_sum(float v) {
#pragma unroll
    for (int o = 1; o < 64; o <<= 1) v += __shfl_xor(v, o);
    return v;
}
__device__ __forceinline__ float fast_rcp(float x) { return __builtin_amdgcn_rcpf(x); }
__device__ __forceinline__ float fast_exp(float x) { return __builtin_amdgcn_exp2f(x * 1.4426950408889634f); }
__device__ __forceinline__ float fast_log(float x) { return __builtin_amdgcn_logf(x) * 0.6931471805599453f; }
__device__ __forceinline__ float fast_rsq(float x) { return __builtin_amdgcn_rsqf(x); }
__device__ __forceinline__ float silu_f(float x) { return x * fast_rcp(1.f + fast_exp(-x)); }
__device__ __forceinline__ f32x2_t silu_f2(f32x2_t x) {
    const f32x2_t t = x * (f32x2_t){-1.4426950408889634f, -1.4426950408889634f};
    f32x2_t e = {__builtin_amdgcn_exp2f(t.x), __builtin_amdgcn_exp2f(t.y)};
    e = e + (f32x2_t){1.f, 1.f};
    return x * (f32x2_t){fast_rcp(e.x), fast_rcp(e.y)};
}
__device__ __forceinline__ f32x2_t bf2f2(unsigned w) { return (f32x2_t){__builtin_bit_cast(float, w << 16), __builtin_bit_cast(float, w & 0xffff0000u)}; }
#define LDS_WAIT() asm volatile("s_waitcnt lgkmcnt(0)" ::: "memory")
__device__ __forceinline__ int opaque_tid() { int t = threadIdx.x; asm volatile("" : "+v"(t)); return t & (NTHREADS - 1); }

struct Params { const float* in[27]; float* out; unsigned char* ws; int pass; int pad; };
typedef const __attribute__((address_space(4))) Params* KP;
__device__ __forceinline__ KP kparams() { KP q = (KP)__builtin_amdgcn_kernarg_segment_ptr(); asm volatile("" : "+s"(q)); return q; }

namespace gm {
constexpr int BM = 256, BK = 64, HALF = 128, HTB = HALF * BK * 2, STAGE_BYTES = 8 * HTB, NXCD = 8, WGM = 8;
constexpr int K = 1024;
constexpr size_t KSTEP = BK * 2;

__device__ __forceinline__ int lds_byte(int r, int c) { return (r >> 3) * 1024 + (r & 7) * 128 + 16 * ((c >> 3) ^ ((r >> 1) & 7)); }
__device__ __forceinline__ void stage_rc(int b, int& R, int& C) { R = 8 * (b >> 10) + ((b >> 7) & 7); C = 8 * (((b >> 4) & 7) ^ ((R >> 1) & 7)); }
__device__ __forceinline__ int perm32(int rho) { const int n = rho >> 4, i = rho & 15; return 8 * (i >> 2) + 4 * n + (i & 3); }

struct Unit { int arow, nvalid, pn, bsel, orow; };

struct StaticSched {
    int nM, nN, nwg, G, c;
    __device__ void init(int nM_, int nN_, int G_, int c_) { nM = nM_; nN = nN_; nwg = nM * nN; G = G_; c = c_; }
    __device__ bool next(int i, Unit& u) const {
        const long L = (long)i * G + c; if (L >= nwg) return false;
        int wgid = (int)L; { const int q = nwg / NXCD, r = nwg % NXCD, xcd = wgid % NXCD, off = wgid / NXCD; wgid = (xcd < r ? xcd * (q + 1) : r * (q + 1) + (xcd - r) * q) + off; }
        const int nig = WGM * nN, gid = wgid / nig, fm = gid * WGM, gsz = (nM - fm) < WGM ? (nM - fm) : WGM;
        const int pm = fm + ((wgid % nig) % gsz), pn = (wgid % nig) / gsz;
        u.arow = pm * BM; u.nvalid = BM; u.pn = pn; u.bsel = 0; u.orow = pm * BM; return true;
    }
};

struct MoeSched {
    const int* cnt; int e0, e1, npn, G, c, ybase0; bool second;
    mutable int pe, pbase, phrow;
    __device__ void reset() { pe = e0; pbase = 0; phrow = 0; }
    __device__ bool next(int i, Unit& u) const {
        const long L = (long)i * G + c;
        while (pe < e1) {
            const int n = cnt[pe], nrb = (n + 255) >> 8, ntile = nrb * npn;
            if (L < (long)pbase + ntile) {
                const int l = (int)(L - pbase), nig = WGM * npn, grp = l / nig, within = l % nig, fm = grp * WGM, gsz = (nrb - fm) < WGM ? (nrb - fm) : WGM;
                const int rb = fm + within % gsz, pn = within / gsz;
                u.pn = pn; u.bsel = pe;
                if (!second) { u.arow = pe * NTOK + rb * 256; u.nvalid = n - rb * 256; u.orow = phrow + rb * 256; }
                else { u.arow = phrow + rb * 256; u.nvalid = BM; u.orow = ybase0 + phrow + rb * 256; }
                return true;
            }
            pbase += ntile; phrow += nrb * 256; ++pe;
        }
        return false;
    }
};

typedef int v8i __attribute__((ext_vector_type(8)));
__device__ __forceinline__ bf16x8 ld_half8(const LAS unsigned char* p) { const s16x4 lo = *(const LAS s16x4*)p; return __builtin_bit_cast(bf16x8, __builtin_shufflevector(lo, lo, 0, 1, 2, 3, -1, -1, -1, -1)); }
template <bool F8, bool F6, bool F6B> __device__ __forceinline__ f32x4 mma_step(const bf16x8 (&b)[2], const bf16x8 (&a)[2], f32x4 c) {
    if constexpr (F8) {
        const v8i bb = __builtin_bit_cast(v8i, __builtin_shufflevector(b[0], b[1], 0, 1, 2, 3, 4, 5, 6, 7, 8, 9, 10, 11, 12, 13, 14, 15));
        const v8i aa = __builtin_bit_cast(v8i, __builtin_shufflevector(a[0], a[1], 0, 1, 2, 3, 4, 5, 6, 7, 8, 9, 10, 11, 12, 13, 14, 15));
        if constexpr (F6) return __builtin_amdgcn_mfma_scale_f32_16x16x128_f8f6f4(bb, aa, c, 2, 2, 0, 0x7f7f7f7f, 0, 0x7f7f7f7f);
        else if constexpr (F6B) return __builtin_amdgcn_mfma_scale_f32_16x16x128_f8f6f4(bb, aa, c, 2, 0, 0, 0x7f7f7f7f, 0, 0x7f7f7f7f);
        else return __builtin_amdgcn_mfma_scale_f32_16x16x128_f8f6f4(bb, aa, c, 0, 0, 0, 0x7f7f7f7f, 0, 0x7f7f7f7f);
    } else {
        c = __builtin_amdgcn_mfma_f32_16x16x32_bf16(b[0], a[0], c, 0, 0, 0);
        return __builtin_amdgcn_mfma_f32_16x16x32_bf16(b[1], a[1], c, 0, 0, 0);
    }
}
template <class Epi, class Sched, bool GATHER, bool F8, bool F6 = false, bool F6B = false>
__device__ __forceinline__ void gemm_phase(LAS unsigned char* lds, const bf16_t* Abase, const bf16_t* Btbase, size_t bsel_bytes, const int* glist, const Sched& S, const Epi& E) {
    const int tid = opaque_tid(), wid = __builtin_amdgcn_readfirstlane(tid >> 6), lane = tid & 63, wr = wid >> 2, wc = wid & 3, fr = lane & 15, fq = lane >> 4;
    constexpr int RB = F8 ? K : 2 * K, NT = RB / 128;
    constexpr int RBB = F8 ? W8_PITCH : RB;
    constexpr size_t HSTEP = (size_t)HALF * RB, TSTEP = (size_t)BM * RBB, BHALF = (size_t)32 * RBB;
    unsigned voffB[2]; unsigned long long dmask = ~0ull;
    { int R0, C0, R1, C1; stage_rc(tid * 16, R0, C0); stage_rc(tid * 16 + 8192, R1, C1);
      if (F6 || F6B) dmask = __builtin_amdgcn_ballot_w64(C0 < 48);
      const int Rb0 = 64 * (R0 >> 5) + perm32(R0 & 31), Rb1 = 64 * (R1 >> 5) + perm32(R1 & 31);
      voffB[0] = (unsigned)(Rb0 * RBB + C0 * 2); voffB[1] = (unsigned)(Rb1 * RBB + C1 * 2); }
    const unsigned ldsw = (unsigned)wid * 1024u;
    const int pa = F6 ? fq : (F6B ? fq : (F8 ? (fq & 1) + 4 * (fq >> 1) : fq)), pb = F6 ? 4 + (fq >> 1) : (F6B ? 4 + fq : (F8 ? pa + 2 : 4 + fq)), ph = F6 ? 8 * (fq & 1) : 0;
    const int pa6 = (F6 || F6B) ? fq : pa, pb6 = (F6 || F6B) ? 4 + (fq >> 1) : pb, ph6 = (F6 || F6B) ? 8 * (fq & 1) : 0;
    const int aoff = lds_byte(wr * 64 + fr, 8 * pa), aoff2 = lds_byte(wr * 64 + fr, 8 * pb) + ph, boff = lds_byte(wc * 32 + fr, 8 * pa6), boff2 = lds_byte(wc * 32 + fr, 8 * pb6) + ph6;
#define G_SA(b, h) (((b) * 2 + (h)) * HTB)
#define G_SB(b, h) ((4 + (b) * 2 + (h)) * HTB)
#define G_STAGE2M(MASKED, bufoff, gbase, o0, o1) do { \
        if (MASKED) { unsigned m0s_; asm volatile("s_mov_b32 %0, m0\n\ts_mov_b32 m0, %1\n\ts_mov_b64 exec, %3\n\tglobal_load_lds_dwordx4 %4, %6\n\ts_mov_b32 m0, %2\n\ts_nop 0\n\tglobal_load_lds_dwordx4 %5, %6\n\ts_mov_b64 exec, -1\n\ts_mov_b32 m0, %0" \
                : "=&s"(m0s_) : "s"((unsigned)(size_t)(lds + (bufoff) + ldsw)), "s"((unsigned)(size_t)(lds + (bufoff) + ldsw + 8192)), "s"(dmask), "v"((unsigned)(o0)), "v"((unsigned)(o1)), "s"((const char*)(gbase)) : "memory"); } \
        else { \
        __builtin_amdgcn_global_load_lds((const unsigned*)((const char*)(gbase) + (o0)), (LAS unsigned*)(lds + (bufoff) + ldsw), 16, 0, 0); \
        __builtin_amdgcn_global_load_lds((const unsigned*)((const char*)(gbase) + (o1)), (LAS unsigned*)(lds + (bufoff) + ldsw + 8192), 16, 0, 0); } } while (0)
#define G_STAGE2(bufoff, gbase, o0, o1) G_STAGE2M(F6, bufoff, gbase, o0, o1)
#define G_STAGE2B(bufoff, gbase, o0, o1) G_STAGE2M(F6 || F6B, bufoff, gbase, o0, o1)
#define G_LD2(ptr) (F6 ? ld_half8(ptr) : *(const LAS bf16x8*)(ptr))
#define G_LD2B(ptr) ((F6 || F6B) ? ld_half8(ptr) : *(const LAS bf16x8*)(ptr))
#define G_LDA(dst, b, h) do { _Pragma("unroll") for (int m = 0; m < 4; ++m) { dst[m][0] = *(const LAS bf16x8*)(lds + G_SA(b, h) + aoff + m * 2048); dst[m][1] = G_LD2(lds + G_SA(b, h) + aoff2 + m * 2048); } } while (0)
#define G_LDB(dst, b, h) do { _Pragma("unroll") for (int n = 0; n < 2; ++n) { dst[n][0] = *(const LAS bf16x8*)(lds + G_SB(b, h) + boff + n * 2048); dst[n][1] = G_LD2B(lds + G_SB(b, h) + boff2 + n * 2048); } } while (0)
#define G_MMA(ai, bj, At, Bt) do { __builtin_amdgcn_s_setprio(1); _Pragma("unroll") for (int m = 0; m < 4; ++m) _Pragma("unroll") for (int n = 0; n < 2; ++n) \
        acc[ai][bj][m][n] = mma_step<F8, F6, F6B>(Bt[n], At[m], acc[ai][bj][m][n]); __builtin_amdgcn_s_setprio(0); } while (0)
#define G_WAIT_V(n) asm volatile("s_waitcnt vmcnt(" #n ")" ::: "memory")
#define G_WAIT_L(n) asm volatile("s_waitcnt lgkmcnt(" #n ")" ::: "memory")
#define G_WAIT_V8R(fresh) do { if (Epi::NST > 0 && (fresh)) { if (Epi::NST == 16) asm volatile("s_waitcnt vmcnt(24)" ::: "memory"); else asm volatile("s_waitcnt vmcnt(16)" ::: "memory"); } \
        else asm volatile("s_waitcnt vmcnt(8)" ::: "memory"); } while (0)
#define G_BAR __builtin_amdgcn_s_barrier()
#define G_SCHED __builtin_amdgcn_sched_barrier(0)
#define G_TOK(tk, u) do { int R0, C0, R1, C1; { const int t2 = opaque_tid(); stage_rc(t2 * 16, R0, C0); stage_rc(t2 * 16 + 8192, R1, C1); } if (GATHER) { \
            tk[0] = R0 < (u).nvalid ? glist[(u).arow + R0] : 0; tk[1] = R1 < (u).nvalid ? glist[(u).arow + R1] : 0; \
            tk[2] = 128 + R0 < (u).nvalid ? glist[(u).arow + 128 + R0] : 0; tk[3] = 128 + R1 < (u).nvalid ? glist[(u).arow + 128 + R1] : 0; } \
        else { tk[0] = (u).arow + R0; tk[1] = (u).arow + R1; tk[2] = (u).arow + 128 + R0; tk[3] = (u).arow + 128 + R1; } } while (0)
#define G_AOFF(dst, tk) do { int R0, C0, R1, C1; { const int t2 = opaque_tid(); stage_rc(t2 * 16, R0, C0); stage_rc(t2 * 16 + 8192, R1, C1); } dst[0][0] = (unsigned)(tk[0] * RB + C0 * 2); dst[0][1] = (unsigned)(tk[1] * RB + C1 * 2); dst[1][0] = (unsigned)(tk[2] * RB + C0 * 2); dst[1][1] = (unsigned)(tk[3] * RB + C1 * 2); } while (0)
    Unit cur, nxt; int ui = 0; bool relax = false;
    if (!S.next(0, cur)) return;
    f32x4 acc[2][2][4][2];
#pragma unroll
    for (int a = 0; a < 2; ++a)
#pragma unroll
        for (int b = 0; b < 2; ++b)
#pragma unroll
            for (int m = 0; m < 4; ++m)
#pragma unroll
                for (int n = 0; n < 2; ++n) acc[a][b][m][n] = (f32x4){0.f, 0.f, 0.f, 0.f};
    bf16x8 At[4][2], B0[2][2], B1[2][2];
    unsigned ao[2][2]; int tk[4];
    G_TOK(tk, cur); G_AOFF(ao, tk);
    LAS unsigned char* const lbias = lds + STAGE_BYTES + 1024;
    if (Epi::HAS_BIAS && wid == 1) __builtin_amdgcn_global_load_lds((const unsigned*)E.bias_ptr(cur, lane), (LAS unsigned*)lbias, 16, 0, 0);
    const char* const cA = (const char*)Abase;
    const char* cB = (const char*)Btbase + (size_t)cur.bsel * bsel_bytes + (size_t)cur.pn * TSTEP;
    G_STAGE2B(G_SB(0, 0), cB, voffB[0], voffB[1]); G_STAGE2B(G_SB(0, 1), cB + BHALF, voffB[0], voffB[1]); G_STAGE2(G_SA(0, 0), cA, ao[0][0], ao[0][1]); G_STAGE2(G_SA(0, 1), cA, ao[1][0], ao[1][1]);
    if (wr == 1) G_BAR;
    G_WAIT_V(2); G_BAR;
    G_STAGE2B(G_SB(1, 0), cB + KSTEP, voffB[0], voffB[1]); G_STAGE2(G_SA(1, 0), cA + KSTEP, ao[0][0], ao[0][1]); G_STAGE2B(G_SB(1, 1), cB + BHALF + KSTEP, voffB[0], voffB[1]);
    G_WAIT_V(6); G_BAR;
    for (;;) {
        const bool has_next = S.next(ui + 1, nxt);
        const char* nB = has_next ? (const char*)Btbase + (size_t)nxt.bsel * bsel_bytes + (size_t)nxt.pn * TSTEP : cB;
#pragma unroll 1
        for (int t = 0; t < NT; t += 2) {
            const bool last = (t == NT - 2);
            if (Epi::HAS_BIAS && t == NT - 4 && has_next && wid == 1)
                __builtin_amdgcn_global_load_lds((const unsigned*)E.bias_ptr(nxt, lane), (LAS unsigned*)(lbias + 1024 * ((ui + 1) & 1)), 16, 0, 0);
            if (GATHER && t == NT - 4 && has_next && wid == 0)
                __builtin_amdgcn_global_load_lds((const unsigned*)(glist + nxt.arow + 4 * lane), (LAS unsigned*)(lds + STAGE_BYTES), 16, 0, 0);
            const char* a1 = cA + (size_t)(t + 1) * KSTEP;
            const char* a2 = last ? cA : cA + (size_t)(t + 2) * KSTEP; const char* b2 = last ? nB : cB + (size_t)(t + 2) * KSTEP;
            const char* a3 = a2 + KSTEP; const char* b3 = b2 + KSTEP;
            G_LDB(B0, 0, 0); G_LDB(B1, 0, 1); G_SCHED; G_LDA(At, 0, 0); G_STAGE2(G_SA(1, 1), a1, ao[1][0], ao[1][1]);
            if (last && has_next) {
                if (GATHER) { int R0, C0, R1, C1; { const int t2 = opaque_tid(); stage_rc(t2 * 16, R0, C0); stage_rc(t2 * 16 + 8192, R1, C1); }
                    const LAS int* tl = (const LAS int*)(lds + STAGE_BYTES);
                    tk[0] = R0 < nxt.nvalid ? tl[R0] : 0; tk[1] = R1 < nxt.nvalid ? tl[R1] : 0; tk[2] = 128 + R0 < nxt.nvalid ? tl[128 + R0] : 0; tk[3] = 128 + R1 < nxt.nvalid ? tl[128 + R1] : 0; }
                else G_TOK(tk, nxt);
                G_AOFF(ao, tk); }
            const bool fresh = relax && t == 0;
            G_WAIT_V8R(fresh); G_WAIT_L(0); G_BAR; G_MMA(0, 0, At, B0); G_MMA(0, 1, At, B1); G_BAR; G_SCHED;
            G_LDA(At, 0, 1); G_STAGE2B(G_SB(0, 0), b2, voffB[0], voffB[1]); G_STAGE2B(G_SB(0, 1), b2 + BHALF, voffB[0], voffB[1]); G_STAGE2(G_SA(0, 0), a2, ao[0][0], ao[0][1]);
            G_WAIT_V8R(fresh); G_WAIT_L(0); G_BAR; G_MMA(1, 0, At, B0); G_MMA(1, 1, At, B1); G_BAR; G_SCHED;
            G_LDB(B0, 1, 0); G_LDB(B1, 1, 1); G_SCHED; G_LDA(At, 1, 0); G_STAGE2(G_SA(0, 1), a2, ao[1][0], ao[1][1]);
            G_WAIT_V(8); G_WAIT_L(0); G_BAR; G_MMA(0, 0, At, B0); G_MMA(0, 1, At, B1); G_BAR; G_SCHED;
            G_LDA(At, 1, 1); G_STAGE2B(G_SB(1, 0), b3, voffB[0], voffB[1]); G_STAGE2B(G_SB(1, 1), b3 + BHALF, voffB[0], voffB[1]); G_STAGE2(G_SA(1, 0), a3, ao[0][0], ao[0][1]);
            G_WAIT_V(8); G_WAIT_L(0); G_BAR; G_MMA(1, 0, At, B0); G_MMA(1, 1, At, B1); G_BAR; G_SCHED;
        }
        if (wr == 0) G_BAR;
        E(acc, cur, wr, wc, fr, fq, (const LAS float*)(lbias + 1024 * (ui & 1)));
        if (!has_next) break;
        relax = E.nst_holds(cur);
#pragma unroll
        for (int a = 0; a < 2; ++a)
#pragma unroll
            for (int b = 0; b < 2; ++b)
#pragma unroll
                for (int m = 0; m < 4; ++m)
#pragma unroll
                    for (int n = 0; n < 2; ++n) acc[a][b][m][n] = (f32x4){0.f, 0.f, 0.f, 0.f};
        cur = nxt; cB = nB; ++ui;
        if (wr == 1) G_BAR;
    }
    G_WAIT_V(0);
    G_BAR;
#undef G_SA
#undef G_SB
#undef G_STAGE2
#undef G_STAGE2B
#undef G_STAGE2M
#undef G_LD2B
#undef G_LD2
#undef G_LDA
#undef G_LDB
#undef G_MMA
#undef G_WAIT_V
#undef G_WAIT_L
#undef G_WAIT_V8R
#undef G_BAR
#undef G_SCHED
#undef G_AOFF
#undef G_TOK
}

__device__ __forceinline__ unsigned dpp_ror8(unsigned v) { return (unsigned)__builtin_amdgcn_mov_dpp((int)v, 0x128, 0xf, 0xf, true); }
__device__ __forceinline__ void store_lines(bf16_t* g16  , size_t pitch, int fr, const u32x4& w0, const u32x4& w1) {
    const bool lo = fr < 8;
    const u32x4 t = lo ? w1 : w0;
    u32x4 r; r.x = dpp_ror8(t.x); r.y = dpp_ror8(t.y); r.z = dpp_ror8(t.z); r.w = dpp_ror8(t.w);
    bf16_t* pa = g16 + (size_t)(fr & 7) * pitch + (lo ? 0 : 32);
    *(u32x4*)pa = lo ? w0 : r;
    *(u32x4*)(pa + 8 * pitch) = lo ? r : w1;
}
struct EpiProj {
    static constexpr bool PERM = true;
    static constexpr bool HAS_BIAS = false;
    static constexpr int NST = 16;
    __device__ __forceinline__ bool nst_holds(const Unit& u) const { return u.arow != NTOK; }
    bf16_t* P;
    __device__ __forceinline__ const float* bias_ptr(const Unit&, int) const { return nullptr; }
    __device__ __forceinline__ void operator()(const f32x4 (&acc)[2][2][4][2], const Unit& u, int wr, int wc, int fr, int fq, const LAS float*) const {
        const int col0 = u.pn * BM + wc * 64 + 8 * fq;
        const bool meta = (u.arow == NTOK);
        const int pm = u.arow >> 8;
        const int orow0 = u.arow + 64 * ((pm >> 3) + 1);
#pragma unroll
        for (int ai = 0; ai < 2; ++ai)
#pragma unroll
            for (int m = 0; m < 4; ++m) {
                const int lr0 = ai * HALF + wr * 64 + m * 16, lr = lr0 + fr;
                u32x4 w[2];
#pragma unroll
                for (int bj = 0; bj < 2; ++bj) { const f32x4 v0 = acc[ai][bj][m][0], v1 = acc[ai][bj][m][1];
                    w[bj].x = cvt_pk_bf16(v0[0], v0[1]); w[bj].y = cvt_pk_bf16(v0[2], v0[3]); w[bj].z = cvt_pk_bf16(v1[0], v1[1]); w[bj].w = cvt_pk_bf16(v1[2], v1[3]); }
                if (!meta) store_lines(P + (size_t)(orow0 + lr0) * LDP + col0, LDP, fr, w[0], w[1]);
                else if (lr < NMETA) { for (int b = 0; b < NB; ++b) { bf16_t* q = P + (size_t)(b * LP + 48 + lr) * LDP + col0; *(u32x4*)q = w[0]; *(u32x4*)(q + 32) = w[1]; } }
            }
    }
};
struct EpiOut {
    static constexpr bool PERM = true;
    static constexpr bool HAS_BIAS = false;
    static constexpr int NST = 0;
    __device__ __forceinline__ bool nst_holds(const Unit& u) const { return false; }
    const bf16_t* H; bf16_t* V;
    __device__ __forceinline__ const float* bias_ptr(const Unit&, int) const { return nullptr; }
    __device__ __forceinline__ void operator()(const f32x4 (&acc)[2][2][4][2], const Unit& u, int wr, int wc, int fr, int fq, const LAS float*) const {
        const int col0 = u.pn * BM + wc * 64 + 8 * fq;
#pragma unroll
        for (int ai = 0; ai < 2; ++ai)
#pragma unroll
            for (int m = 0; m < 4; ++m) {
                const size_t row0 = (size_t)(u.arow + ai * HALF + wr * 64 + m * 16), row = row0 + fr;
                u32x4 w[2];
#pragma unroll
                for (int bj = 0; bj < 2; ++bj) {
                    const u32x4 h = *(const u32x4*)(H + row * D + col0 + bj * 32);
                    const f32x4 v0 = acc[ai][bj][m][0], v1 = acc[ai][bj][m][1];
                    w[bj].x = cvt_pk_bf16(v0[0] + ALPHA * bf2f(h.x & 0xffffu), v0[1] + ALPHA * bf2f(h.x >> 16));
                    w[bj].y = cvt_pk_bf16(v0[2] + ALPHA * bf2f(h.y & 0xffffu), v0[3] + ALPHA * bf2f(h.y >> 16));
                    w[bj].z = cvt_pk_bf16(v1[0] + ALPHA * bf2f(h.z & 0xffffu), v1[1] + ALPHA * bf2f(h.z >> 16));
                    w[bj].w = cvt_pk_bf16(v1[2] + ALPHA * bf2f(h.w & 0xffffu), v1[3] + ALPHA * bf2f(h.w >> 16));
                }
                store_lines(V + row0 * D + col0, D, fr, w[0], w[1]);
            }
    }
};
__device__ __forceinline__ float swiglu(float a, float u) {
    a = fminf(a, 7.0f); u = fminf(fmaxf(u, -7.0f), 7.0f);
    return a * fast_rcp(1.f + fast_exp(-1.702f * a)) * (u + 1.0f);
}
__device__ __forceinline__ float swiglu8(float a, float u) {
    a = fminf(a, 7.0f); u = fminf(fmaxf(u, -7.0f), 7.0f);
    const float sg = fast_rcp(1.f + __builtin_amdgcn_exp2f(a * (-1.702f * 1.4426950408889634f)));
    return fminf((a * sg) * (u * HID8_SCALE + HID8_SCALE), 448.f);
}
__device__ __forceinline__ f32x2_t swiglu8x2(f32x2_t a, f32x2_t u) {
    a.x = fminf(a.x, 7.0f); a.y = fminf(a.y, 7.0f); u.x = fminf(fmaxf(u.x, -7.0f), 7.0f); u.y = fminf(fmaxf(u.y, -7.0f), 7.0f);
    const f32x2_t t = a * (f32x2_t){-1.702f * 1.4426950408889634f, -1.702f * 1.4426950408889634f};
    f32x2_t e = {__builtin_amdgcn_exp2f(t.x), __builtin_amdgcn_exp2f(t.y)};
    e = e + (f32x2_t){1.f, 1.f};
    const f32x2_t sg = {fast_rcp(e.x), fast_rcp(e.y)};
    return (a * sg) * (u * (f32x2_t){HID8_SCALE, HID8_SCALE} + (f32x2_t){HID8_SCALE, HID8_SCALE});
}
struct EpiSwiglu {
    static constexpr bool PERM = true;
    static constexpr bool HAS_BIAS = true;
    static constexpr int NST = 8;
    __device__ __forceinline__ bool nst_holds(const Unit& u) const { return true; }
    unsigned char* HID; const float* bg; const float* bu;
    __device__ __forceinline__ const float* bias_ptr(const Unit& u, int lane) const { return (lane < 32 ? bg : bu) + (size_t)u.bsel * D + u.pn * HALF + 4 * (lane & 31); }
    __device__ __forceinline__ void operator()(const f32x4 (&acc)[2][2][4][2], const Unit& u, int wr, int wc, int fr, int fq, const LAS float* lb) const {
        const int hc = u.pn * HALF + wc * 32 + 8 * fq, hl_ = wc * 32 + 8 * fq;
        const f32x4 g0 = *(const LAS f32x4*)(lb + hl_), g1 = *(const LAS f32x4*)(lb + hl_ + 4), u0 = *(const LAS f32x4*)(lb + 128 + hl_), u1 = *(const LAS f32x4*)(lb + 128 + hl_ + 4);
        constexpr float IS = 1.0f / (W8_SCALE * H6_SCALE);
#pragma unroll
        for (int ai = 0; ai < 2; ++ai)
#pragma unroll
            for (int m = 0; m < 4; ++m) {
                const size_t row = (size_t)(u.orow + ai * HALF + wr * 64 + m * 16 + fr);
                const f32x4 a0 = acc[ai][0][m][0] * IS + g0, a1 = acc[ai][0][m][1] * IS + g1, b0 = acc[ai][1][m][0] * IS + u0, b1 = acc[ai][1][m][1] * IS + u1;
                u32x2 w;
                const f32x2_t s0 = swiglu8x2((f32x2_t){a0[0], a0[1]}, (f32x2_t){b0[0], b0[1]}), s1 = swiglu8x2((f32x2_t){a0[2], a0[3]}, (f32x2_t){b0[2], b0[3]});
                const f32x2_t s2 = swiglu8x2((f32x2_t){a1[0], a1[1]}, (f32x2_t){b1[0], b1[1]}), s3 = swiglu8x2((f32x2_t){a1[2], a1[3]}, (f32x2_t){b1[2], b1[3]});
                w.x = cvt_fp8x4_nc(s0.x, s0.y, s1.x, s1.y);
                w.y = cvt_fp8x4_nc(s2.x, s2.y, s3.x, s3.y);
                *(u32x2*)(HID + row * D + hc) = w;
            }
    }
};
struct EpiDown {
    static constexpr bool PERM = true;
    static constexpr bool HAS_BIAS = true;
    static constexpr int NST = 16;
    __device__ __forceinline__ bool nst_holds(const Unit& u) const { return true; }
    unsigned char* Y; const float* bd;
    __device__ __forceinline__ const float* bias_ptr(const Unit& u, int lane) const { return bd + (size_t)u.bsel * D + u.pn * BM + 4 * lane; }
    __device__ __forceinline__ void operator()(const f32x4 (&acc)[2][2][4][2], const Unit& u, int wr, int wc, int fr, int fq, const LAS float* lb) const {
        const int col0 = u.pn * BM + wc * 64 + 8 * fq;
        const LAS float* pb = lb + wc * 64 + 8 * fq;
        f32x4 bv[2][2];
#pragma unroll
        for (int bj = 0; bj < 2; ++bj) { bv[bj][0] = *(const LAS f32x4*)(pb + bj * 32) * Y8_SCALE; bv[bj][1] = *(const LAS f32x4*)(pb + bj * 32 + 4) * Y8_SCALE; }
        constexpr float IS = Y8_SCALE / (WD6_SCALE * HID8_SCALE);
#pragma unroll
        for (int ai = 0; ai < 2; ++ai)
#pragma unroll
            for (int m = 0; m < 4; ++m) {
                unsigned char* rowp = Y + (size_t)(u.orow + ai * HALF + wr * 64 + m * 16 + fr) * D + col0;
#pragma unroll
                for (int bj = 0; bj < 2; ++bj) {
                    const f32x4 v0 = acc[ai][bj][m][0] * IS + bv[bj][0], v1 = acc[ai][bj][m][1] * IS + bv[bj][1];
                    u32x2 w; w.x = cvt_fp8x4(v0[0], v0[1], v0[2], v0[3]); w.y = cvt_fp8x4(v1[0], v1[1], v1[2], v1[3]);
                    *(u32x2*)(rowp + bj * 32) = w;
                }
            }
    }
};
}

__device__ __forceinline__ void transpose_item(const float* W, int N, int k0, int n0, bf16_t* WT, int drow0, LAS float* scr, int lane) {
    const int nn = n0 + (lane & 31); const bool ok = nn < N;
#pragma unroll 8
    for (int i = 0; i < 32; ++i) { const int kk = 2 * i + (lane >> 5); scr[kk * 33 + (lane & 31)] = ok ? W[(size_t)(k0 + kk) * N + nn] : 0.f; }
    LDS_WAIT(); asm volatile("" ::: "memory");
    const int c = lane & 7;
#pragma unroll
    for (int j = 0; j < 4; ++j) { const int n = (lane >> 3) + 8 * j; const LAS float* s = scr + (8 * c) * 33 + n;
        u32x4 o; o.x = cvt_pk_bf16(s[0 * 33], s[1 * 33]); o.y = cvt_pk_bf16(s[2 * 33], s[3 * 33]); o.z = cvt_pk_bf16(s[4 * 33], s[5 * 33]); o.w = cvt_pk_bf16(s[6 * 33], s[7 * 33]);
        if (n0 + n < N) *(u32x4*)(WT + (size_t)(drow0 < 0 ? proj_col(n0 + n) : drow0 + n) * D + k0 + 8 * c) = o; }
    LDS_WAIT(); asm volatile("" ::: "memory");
}
__device__ __forceinline__ void ln_row_f32_to_bf16(const float* xrow, const float* g, const float* b, bf16_t* orow, int lane) {
    const f32x4* xr = (const f32x4*)xrow + lane;
    f32x4 v[4]; float s = 0.f;
#pragma unroll
    for (int j = 0; j < 4; ++j) { v[j] = xr[64 * j]; s += (v[j].x + v[j].y) + (v[j].z + v[j].w); }
    const float mean = wave_sum(s) * (1.f / D); float s2 = 0.f;
#pragma unroll
    for (int j = 0; j < 4; ++j) { v[j] = v[j] - mean; s2 += (v[j].x * v[j].x + v[j].y * v[j].y) + (v[j].z * v[j].z + v[j].w * v[j].w); }
    const float rstd = 1.f / sqrtf(wave_sum(s2) * (1.f / D) + LN_EPS);
    u32x2* o8 = (u32x2*)orow + lane;
#pragma unroll
    for (int j = 0; j < 4; ++j) { const f32x4 gg = ((const f32x4*)g)[lane + 64 * j], bb = ((const f32x4*)b)[lane + 64 * j];
        u32x2 w; w.x = cvt_pk_bf16(v[j].x * rstd * gg.x + bb.x, v[j].y * rstd * gg.y + bb.y); w.y = cvt_pk_bf16(v[j].z * rstd * gg.z + bb.z, v[j].w * rstd * gg.w + bb.w);
        o8[64 * j] = w; }
}
__device__ __forceinline__ void transpose_item_f8(const float* W, int N, int k0, int n0, unsigned char* WT, int drow0, LAS float* scr, int lane, float scale) {
    const int kr = lane >> 3, nq = (lane & 7) * 4;
    f32x4 v[8];
#pragma unroll
    for (int i = 0; i < 8; ++i) v[i] = *(const f32x4*)(W + (size_t)(k0 + 8 * i + kr) * N + n0 + nq);
#pragma unroll
    for (int i = 0; i < 8; ++i) { LAS float* s = scr + (8 * i + kr) * 33 + nq; s[0] = v[i].x * scale; s[1] = v[i].y * scale; s[2] = v[i].z * scale; s[3] = v[i].w * scale; }
    LDS_WAIT(); asm volatile("" ::: "memory");
    const int c = lane & 7;
#pragma unroll
    for (int j = 0; j < 4; ++j) { const int n = (lane >> 3) + 8 * j; const LAS float* s = scr + (8 * c) * 33 + n;
        u32x2 o; o.x = cvt_fp8x4(s[0 * 33], s[1 * 33], s[2 * 33], s[3 * 33]); o.y = cvt_fp8x4(s[4 * 33], s[5 * 33], s[6 * 33], s[7 * 33]);
        *(u32x2*)(WT + (size_t)(drow0 + n) * W8_PITCH + k0 + 8 * c) = o; }
    LDS_WAIT(); asm volatile("" ::: "memory");
}
__device__ __forceinline__ void transpose_item_f6(const float* W, int N, int k0, int n0, unsigned char* WT, int drow0, LAS float* scr, int lane, float scale) {
    const int kr = lane >> 3, nq = (lane & 7) * 4;
    f32x4 v[8];
#pragma unroll
    for (int i = 0; i < 8; ++i) v[i] = *(const f32x4*)(W + (size_t)(k0 + 8 * i + kr) * N + n0 + nq);
#pragma unroll
    for (int i = 0; i < 8; ++i) { LAS float* s = scr + (8 * i + kr) * 33 + nq; s[0] = v[i].x * scale; s[1] = v[i].y * scale; s[2] = v[i].z * scale; s[3] = v[i].w * scale; }
    LDS_WAIT(); asm volatile("" ::: "memory");
    const int kb2 = lane >> 5, n = lane & 31; const LAS float* s = scr + (32 * kb2) * 33 + n;
    u32x16 blk;
#pragma unroll
    for (int j = 0; j < 16; ++j) blk[j] = cvt_pk_bf16(s[(2 * j) * 33], s[(2 * j + 1) * 33]);
    const int kk = k0 + 32 * kb2;
    store_fp6_block(WT + (size_t)(drow0 + n) * W8_PITCH + 128 * (kk >> 7), (kk >> 5) & 3, cvt_fp6x32(blk));
    LDS_WAIT(); asm volatile("" ::: "memory");
}
__device__ __forceinline__ void phase_prep(LAS unsigned char* lds, int vcu, int G) {
    const KP p = kparams();
    const int tid = opaque_tid(), lane = tid & 63, wave = __builtin_amdgcn_readfirstlane(tid >> 6);
    LAS float* scr = (LAS float*)(lds + wave * 16384);
    const int gw = vcu * NWAVES + wave, NGW = G * NWAVES;
    bf16_t* WinT = (bf16_t*)(p->ws + WS_WIN); bf16_t* WoutT = (bf16_t*)(p->ws + WS_WOUT);
    bf16_t* H = (bf16_t*)(p->ws + WS_H); bf16_t* PROJ = (bf16_t*)(p->ws + WS_PROJ);
    constexpr int I_IN = 16 * 97, I_OUT = 16 * 32;
    for (int it = gw; it < I_IN + I_OUT; it += NGW) {
        int r = it;
        if (r < I_IN) { const int kb = r / 97, nb = r % 97; transpose_item(p->in[4], NPROJ, 64 * kb, 32 * nb, WinT, -1, scr, lane); continue; } r -= I_IN;
        { const int kb = r / 32, nb = r % 32; transpose_item(p->in[14], D, 64 * kb, 32 * nb, WoutT, 32 * nb, scr, lane); }
    }
    const u32x4 z4 = (u32x4){0u, 0u, 0u, 0u};
    for (int r = gw; r < (LDP - NPROJ) + 240; r += NGW) {
        bf16_t* row = r < (LDP - NPROJ) ? WinT + (size_t)(NPROJ + r) * D : H + (size_t)(NTOK + NMETA + (r - (LDP - NPROJ))) * D;
        ((u32x4*)row)[lane] = z4; ((u32x4*)row)[lane + 64] = z4;
    }
    for (int r = gw; r < NB * 48; r += NGW) { u32x4* row = (u32x4*)(PROJ + (size_t)((r / 48) * LP + (r % 48)) * LDP); for (int j = lane; j < LDP / 8; j += 64) row[j] = z4; }
    { const f32x4* gp = (const f32x4*)p->in[2]; const f32x4* bp = (const f32x4*)p->in[3];
      f32x4 gg[4], bb[4];
#pragma unroll
      for (int j = 0; j < 4; ++j) { gg[j] = gp[lane + 64 * j]; bb[j] = bp[lane + 64 * j]; }
      f32x4 vn[4][4];
#define P0_FETCH(mm0) do { _Pragma("unroll") for (int r = 0; r < 4; ++r) { const int m = (mm0) + r; \
            const f32x4* xr = (const f32x4*)(m < NTOK ? p->in[0] + (size_t)m * D : p->in[1] + (size_t)(m - NTOK) * D) + lane; \
            _Pragma("unroll") for (int j = 0; j < 4; ++j) vn[r][j] = xr[64 * j]; } } while (0)
      if (4 * gw < NTOK + NMETA) P0_FETCH(4 * gw);
#pragma unroll 1
      for (int m0 = 4 * gw; m0 < NTOK + NMETA; m0 += 4 * NGW) {
        f32x4 v[4][4];
#pragma unroll
        for (int r = 0; r < 4; ++r)
#pragma unroll
            for (int j = 0; j < 4; ++j) v[r][j] = vn[r][j];
        if (m0 + 4 * NGW < NTOK + NMETA) P0_FETCH(m0 + 4 * NGW);
#pragma unroll
        for (int r = 0; r < 4; ++r) {
            float s = 0.f;
#pragma unroll
            for (int j = 0; j < 4; ++j) s += (v[r][j].x + v[r][j].y) + (v[r][j].z + v[r][j].w);
            const float mean = wave_sum(s) * (1.f / D); float s2 = 0.f;
#pragma unroll
            for (int j = 0; j < 4; ++j) { v[r][j] = v[r][j] - mean; s2 += (v[r][j].x * v[r][j].x + v[r][j].y * v[r][j].y) + (v[r][j].z * v[r][j].z + v[r][j].w * v[r][j].w); }
            const float rstd = fast_rsq(wave_sum(s2) * (1.f / D) + LN_EPS);
            u32x2* o8 = (u32x2*)(H + (size_t)(m0 + r) * D) + lane;
#pragma unroll
            for (int j = 0; j < 4; ++j) { u32x2 w; w.x = cvt_pk_bf16(v[r][j].x * rstd * gg[j].x + bb[j].x, v[r][j].y * rstd * gg[j].y + bb[j].y);
                w.y = cvt_pk_bf16(v[r][j].z * rstd * gg[j].z + bb[j].z, v[r][j].w * rstd * gg[j].w + bb[j].w); o8[64 * j] = w; }
        }
      } }
#undef P0_FETCH
}

__device__ __forceinline__ f32x16 mfma32(bf16x8 a, bf16x8 b, f32x16 c) { return __builtin_amdgcn_mfma_f32_32x32x16_bf16(a, b, c, 0, 0, 0); }
__device__ __forceinline__ int crow(int reg, int h) { return (reg & 3) + 8 * (reg >> 2) + 4 * h; }
__device__ __forceinline__ int swz(int row) { return ((row & 3) << 2) | ((row >> 2) & 3); }
template <int PITCH> __device__ __forceinline__ int img_off(int row, int col) { return PITCH * row + 16 * ((col >> 3) ^ swz(row)) + 2 * (col & 7); }
template <int PITCH> __device__ __forceinline__ bf16x8 tr_frag(LAS unsigned char* img, int cb, int ks, int lane) {
    const int h = lane >> 5, blk = (lane >> 4) & 1, q = (lane & 15) >> 2, p2 = lane & 3;
    const int row = 16 * ks + 8 * h + q, col = cb + 16 * blk + 4 * p2;
    const s16x4 lo = __builtin_amdgcn_ds_read_tr16_b64_v4i16((LAS s16x4*)(img + img_off<PITCH>(row, col)));
    const s16x4 hi = __builtin_amdgcn_ds_read_tr16_b64_v4i16((LAS s16x4*)(img + img_off<PITCH>(row + 4, col)));
    return __builtin_shufflevector(lo, hi, 0, 1, 2, 3, 4, 5, 6, 7);
}
template <int PITCH> __device__ __forceinline__ bf16x8 rowp_frag(LAS unsigned char* img, int row, int c1) {
    const s16x4 lo = *(const LAS s16x4*)(img + img_off<PITCH>(row, c1)), hi = *(const LAS s16x4*)(img + img_off<PITCH>(row, c1 + 8));
    return __builtin_shufflevector(lo, hi, 0, 1, 2, 3, 4, 5, 6, 7);
}
#define PACK8(x, s) __builtin_bit_cast(bf16x8, (u32x4){cvt_pk_bf16((x)[8 * (s)], (x)[8 * (s) + 1]), cvt_pk_bf16((x)[8 * (s) + 2], (x)[8 * (s) + 3]), cvt_pk_bf16((x)[8 * (s) + 4], (x)[8 * (s) + 5]), cvt_pk_bf16((x)[8 * (s) + 6], (x)[8 * (s) + 7])})
__device__ __forceinline__ float tr_reduce32(const float (&v)[32], int lane) {
    float a[16], b[8], c[4], d[2];
    { const bool hi = (lane & 16) != 0;
#pragma unroll
      for (int r = 0; r < 16; ++r) { const float keep = hi ? v[r + 16] : v[r], send = hi ? v[r] : v[r + 16]; a[r] = keep + __shfl_xor(send, 16); } }
    { const bool hi = (lane & 8) != 0;
#pragma unroll
      for (int r = 0; r < 8; ++r) { const float keep = hi ? a[r + 8] : a[r], send = hi ? a[r] : a[r + 8]; b[r] = keep + __shfl_xor(send, 8); } }
    { const bool hi = (lane & 4) != 0;
#pragma unroll
      for (int r = 0; r < 4; ++r) { const float keep = hi ? b[r + 4] : b[r], send = hi ? b[r] : b[r + 4]; c[r] = keep + __shfl_xor(send, 4); } }
    { const bool hi = (lane & 2) != 0;
#pragma unroll
      for (int r = 0; r < 2; ++r) { const float keep = hi ? c[r + 2] : c[r], send = hi ? c[r] : c[r + 2]; d[r] = keep + __shfl_xor(send, 2); } }
    { const bool hi = (lane & 1) != 0; const float keep = hi ? d[1] : d[0], send = hi ? d[0] : d[1]; return keep + __shfl_xor(send, 1); }
}
constexpr int MX_RAW = 0, MX_OUT = 98304, MX_AUX = 131072;
constexpr size_t WS_XA = 834 * MiB;
constexpr size_t WS_XW = 10 * MiB;
constexpr size_t WS_KD = 76 * MiB;
constexpr size_t WS_DECG = 109 * MiB;
constexpr size_t WS_DECS = 112 * MiB;
static_assert(WS_XA + (size_t)NB * LP * 1024 * 2 <= 1024 * MiB && WS_XW + (size_t)NB * LP * 512 * 2 <= WS_KD && WS_KD + (size_t)NB * LP * 256 * 2 <= WS_DECG && WS_DECG + (size_t)NB * NCH * 256 * 4 <= WS_DECS && WS_DECS + (size_t)NB * NCH * 8 * 4 <= WS_TLIST, "pre-pass buffers");

__device__ __forceinline__ void convert_batches(LAS unsigned char* lds, int maxb, unsigned per);
__device__ __forceinline__ void phase_pre(LAS unsigned char* lds, int vcu, int G) {
    const KP p = kparams();
    const int tid = opaque_tid(), lane = tid & 63, w = __builtin_amdgcn_readfirstlane(tid >> 6);
    const bf16_t* PROJ = (const bf16_t*)(p->ws + WS_PROJ);
    bf16_t* XA = (bf16_t*)(p->ws + WS_XA); bf16_t* XW = (bf16_t*)(p->ws + WS_XW); bf16_t* KD = (bf16_t*)(p->ws + WS_KD);
    float* DECG = (float*)(p->ws + WS_DECG); float* DECS = (float*)(p->ws + WS_DECS);
    LAS unsigned char* raw_ = lds + MX_RAW; LAS unsigned char* xw_ = lds + MX_OUT;
    LAS unsigned char* dtraw_ = lds + MX_AUX; LAS float* wS_ = (LAS float*)(lds + MX_AUX + 1024); LAS unsigned char* a1raw_ = lds + MX_AUX + 2048; LAS float* qtot_ = (LAS float*)(lds + MX_AUX + 6144);
    const int prow_ = tid >> 3, c7_ = tid & 7, jj_ = tid & 127, qd = tid >> 7;
    u32x4 pf[10], pfa, pfdt; unsigned short ph3 = 0, ph2 = 0, ph1 = 0;
#define PRE_FETCH(it_) do { const int b_ = (it_) / (NCH * 2), r_ = (it_) % (NCH * 2), c_ = r_ >> 1, x_ = r_ & 1; const size_t R0_ = (size_t)b_ * LP + 64 * c_; \
        const bf16_t* rp = PROJ + (R0_ + prow) * LDP + 8 * c7; \
        _Pragma("unroll") for (int k = 0; k < 10; ++k) { const int col = k < 4 ? C_XBC + 256 * x_ + 64 * k : (k < 6 ? C_XBC + 512 + 128 * x_ + 64 * (k - 4) : (k < 8 ? C_XBC + 768 + 128 * x_ + 64 * (k - 6) : C_K + 128 * x_ + 64 * (k - 8))); \
            pf[k] = *(const u32x4*)(rp + col); } \
        if (tid < 128) pfa = *(const u32x4*)(PROJ + (R0_ + (tid >> 1)) * LDP + C_A1 + 8 * (tid & 1)); \
        if (tid < 64) pfdt = *(const u32x4*)(PROJ + (R0_ + tid) * LDP + C_DT); \
        { const int cch_ = tid < 256 ? 256 * x_ + tid : (tid < 384 ? 512 + 128 * x_ + (tid - 256) : 768 + 128 * x_ + (tid - 384)); \
          if (c_ > 0) { const bf16_t* hq = PROJ + R0_ * LDP + C_XBC + cch_; ph3 = *(hq - 3 * (size_t)LDP); ph2 = *(hq - 2 * (size_t)LDP); ph1 = *(hq - (size_t)LDP); } else { ph3 = 0; ph2 = 0; ph1 = 0; } } } while (0)
    constexpr int NIT = NB * NCH * 2;
    const int nfull = NIT / G, nrem = NIT % G;
    const bool odd = (vcu & 1) != 0, extra = !odd && (vcu >> 1) < nrem;
    const int nmine = nfull + (extra ? 1 : 0);
#define PRE_ITEM(j_) ((j_) < nfull ? vcu + G * (j_) : nfull * G + (vcu >> 1))
    if (odd) { convert_batches(lds, 1, 4u); __syncthreads(); }
    LAS float* wa2T = (LAS float*)(lds + MX_AUX + 8192);
    LAS float* baT = wa2T + 4096;
    for (int idx = tid; idx < 4096; idx += NTHREADS) { const int x_ = idx >> 11, q_ = (idx >> 7) & 15, j_ = idx & 127; wa2T[idx] = p->in[5][q_ * 256 + 128 * x_ + j_]; }
    if (tid < 256) baT[tid] = p->in[6][tid];
    float cwv[2][5], dtbv[2], alogv[2];
#pragma unroll
    for (int x_ = 0; x_ < 2; ++x_) { const int cch_ = tid < 256 ? 256 * x_ + tid : (tid < 384 ? 512 + 128 * x_ + (tid - 256) : 768 + 128 * x_ + (tid - 384));
#pragma unroll
        for (int q_ = 0; q_ < 4; ++q_) cwv[x_][q_] = p->in[8][q_ * 1024 + cch_];
        cwv[x_][4] = p->in[9][cch_]; dtbv[x_] = p->in[10][4 * x_ + (w & 3)]; alogv[x_] = -__expf(p->in[11][4 * x_ + (w & 3)]); }
    if (nmine > 0) { const int prow = prow_, c7 = c7_; const int it0_ = PRE_ITEM(0); PRE_FETCH(it0_); }
    for (int jit = 0; jit < nmine; ++jit) {
        const int it = PRE_ITEM(jit);
        int oz = 0; asm volatile("" : "+v"(oz));
        LAS unsigned char* const raw = raw_ + oz; LAS unsigned char* const xw = xw_ + oz; LAS unsigned char* const dtraw = dtraw_ + oz; LAS float* const wS = wS_ + oz;
        LAS unsigned char* const a1raw = a1raw_ + oz; LAS float* const qtot = qtot_ + oz;
        const int prow = prow_ + oz, c7 = c7_ + oz, jj = jj_ + oz;
        const int b = it / (NCH * 2), r = it % (NCH * 2), c = r >> 1, x = r & 1;
        const size_t R0 = (size_t)b * LP + 64 * c;
#pragma unroll
        for (int k = 0; k < 8; ++k) *(LAS u32x4*)(raw + 1536 * prow + 16 * ((8 * k + c7) ^ swz(prow))) = pf[k];
#pragma unroll
        for (int k = 0; k < 2; ++k) *(LAS u32x4*)(raw + 1536 * prow + 16 * ((64 + 8 * k + c7) ^ swz(prow))) = pf[8 + k];
        if (tid < 64) *(LAS u32x4*)(dtraw + 16 * tid) = pfdt;
        if (tid < 128) { LAS f32x4* ap = (LAS f32x4*)(a1raw + 32 * tid);
            ap[0] = (f32x4){bf2f(pfa.x & 0xffffu), bf2f(pfa.x >> 16), bf2f(pfa.y & 0xffffu), bf2f(pfa.y >> 16)}; ap[1] = (f32x4){bf2f(pfa.z & 0xffffu), bf2f(pfa.z >> 16), bf2f(pfa.w & 0xffffu), bf2f(pfa.w >> 16)}; }
        float xm3 = bf2f(ph3), xm2 = bf2f(ph2), xm1 = bf2f(ph1);
        __syncthreads();
        if (jit + 1 < nmine) { const int itn_ = PRE_ITEM(jit + 1); PRE_FETCH(itn_); }
        const int kcol = 128 * x + jj;
        float cl[16];
        { float run = 0.f; float wa2[16];
#pragma unroll
          for (int q = 0; q < 16; ++q) wa2[q] = wa2T[(16 * x + q) * 128 + jj];
          const float ba = baT[kcol];
#pragma unroll
          for (int f = 0; f < 16; ++f) { const int i = 16 * qd + f;
              const LAS f32x4* ap = (const LAS f32x4*)(a1raw + 64 * i); const f32x4 x0 = ap[0], x1 = ap[1], x2 = ap[2], x3 = ap[3];
              float gq = ba;
              gq += x0.x * wa2[0] + x0.y * wa2[1] + x0.z * wa2[2] + x0.w * wa2[3];
              gq += x1.x * wa2[4] + x1.y * wa2[5] + x1.z * wa2[6] + x1.w * wa2[7];
              gq += x2.x * wa2[8] + x2.y * wa2[9] + x2.z * wa2[10] + x2.w * wa2[11];
              gq += x3.x * wa2[12] + x3.y * wa2[13] + x3.z * wa2[14] + x3.w * wa2[15];
              float la = (fminf(gq, 0.f) - fast_log(1.f + fast_exp(-fabsf(gq)))) * (1.0f / 16.0f);
              if (c == 0 && i < 48) la = 0.f;
              run += la; cl[f] = run; }
          qtot[qd * 128 + jj] = run; }
        if (w < 4) {
            const float rawdt = bf2f(*(const LAS bf16_t*)(dtraw + 16 * lane + 2 * (4 * x + w))) + (x ? dtbv[1] : dtbv[0]);
            float dt = fmaxf(rawdt, 0.f) + fast_log(1.f + fast_exp(-fabsf(rawdt)));
            if (c == 0 && lane < 48) dt = 0.f;
            float cum = dt * (x ? alogv[1] : alogv[0]);
#pragma unroll
            for (int o = 1; o < 64; o <<= 1) { const float t = __shfl_up(cum, o); if (lane >= o) cum += t; }
            const float total = __shfl(cum, 63);
            wS[w * 64 + lane] = fast_exp(total - cum) * dt;
            if (lane == 0) DECS[((size_t)b * NCH + c) * 8 + 4 * x + w] = fast_exp(total);
        }
        __syncthreads();
        { const float t0 = qtot[jj], t1 = qtot[128 + jj], t2 = qtot[256 + jj], t3 = qtot[384 + jj];
          const float total = (t0 + t1) + (t2 + t3);
          const float offs = qd == 0 ? 0.f : (qd == 1 ? t0 : (qd == 2 ? t0 + t1 : t0 + t1 + t2));
          { LAS unsigned char* kg = raw + 1536 * 16 * qd; const int tb = 16 * ((512 + jj) >> 3) + 2 * (jj & 7);
#pragma unroll
            for (int f = 0; f < 16; ++f) { LAS bf16_t* kp = (LAS bf16_t*)(kg + 1536 * f + (tb ^ (16 * (((f & 3) << 2) | ((f >> 2) & 3)))));
                *kp = f2bf(bf2f(*kp) * fast_exp(total - (offs + cl[f]))); } }
          if (qd == 0) DECG[((size_t)b * NCH + c) * 256 + kcol] = fast_exp(total); }
        { const int cch = tid < 256 ? 256 * x + tid : (tid < 384 ? 512 + 128 * x + (tid - 256) : 768 + 128 * x + (tid - 384));
          const float cw0 = x ? cwv[1][0] : cwv[0][0], cw1 = x ? cwv[1][1] : cwv[0][1], cw2 = x ? cwv[1][2] : cwv[0][2], cw3 = x ? cwv[1][3] : cwv[0][3], cb = x ? cwv[1][4] : cwv[0][4];
          const int to = tid + oz; const int tb = 16 * (to >> 3) + 2 * (to & 7);
#pragma unroll 1
          for (int i0 = 0; i0 < 64; i0 += 16) {
            LAS unsigned char* rg = raw + 1536 * i0;
#pragma unroll
            for (int f = 0; f < 16; f += 2) {
                LAS bf16_t* ep0 = (LAS bf16_t*)(rg + 1536 * f + (tb ^ (16 * (((f & 3) << 2) | ((f >> 2) & 3)))));
                LAS bf16_t* ep1 = (LAS bf16_t*)(rg + 1536 * (f + 1) + (tb ^ (16 * ((((f + 1) & 3) << 2) | (((f + 1) >> 2) & 3)))));
                const float xa_ = bf2f(*ep0), xb_ = bf2f(*ep1);
                const float va = cw0 * xm3 + cw1 * xm2 + cw2 * xm1 + cw3 * xa_ + cb, vb = cw0 * xm2 + cw1 * xm1 + cw2 * xa_ + cw3 * xb_ + cb;
                xm3 = xm1; xm2 = xa_; xm1 = xb_;
                const f32x2_t a2 = silu_f2((f32x2_t){va, vb});
                *ep0 = f2bf(a2.x); *ep1 = f2bf(a2.y); }
          } }
        __syncthreads();
        { bf16_t* xa = XA + (R0 + prow) * 1024 + 8 * c7; bf16_t* xq = XW + (R0 + prow) * 512 + 256 * x + 8 * c7; bf16_t* kd = KD + (R0 + prow) * 256 + 128 * x + 8 * c7;
#pragma unroll
          for (int k = 0; k < 8; ++k) { const int col = k < 4 ? 256 * x + 64 * k : (k < 6 ? 512 + 128 * x + 64 * (k - 4) : 768 + 128 * x + 64 * (k - 6));
              const u32x4 v = *(const LAS u32x4*)(raw + 1536 * prow + 16 * ((8 * k + c7) ^ swz(prow)));
              *(u32x4*)(xa + col) = v;
              if (k < 4) { const float wv = wS[64 * k + prow]; const f32x2_t w2 = {wv, wv}; u32x4 o;
#pragma unroll
                  for (int e = 0; e < 4; ++e) { const f32x2_t t = bf2f2(v[e]) * w2; o[e] = cvt_pk_bf16(t.x, t.y); }
                  *(u32x4*)(xq + 64 * k) = o; } }
#pragma unroll
          for (int k = 0; k < 2; ++k) *(u32x4*)(kd + 64 * k) = *(const LAS u32x4*)(raw + 1536 * prow + 16 * ((64 + 8 * k + c7) ^ swz(prow))); }
        __syncthreads();
    }
#undef PRE_FETCH
#undef PRE_ITEM
    if (!odd && !extra) convert_batches(lds, 1, 4u);
}

__device__ __forceinline__ void gla_unit(LAS unsigned char* lds, int b, int hp) {
    const KP p = kparams();
    const int tid = opaque_tid(), lane = tid & 63, w = __builtin_amdgcn_readfirstlane(tid >> 6);
    const bf16_t* PROJ = (const bf16_t*)(p->ws + WS_PROJ); const bf16_t* KD = (const bf16_t*)(p->ws + WS_KD); const float* DECG = (const float*)(p->ws + WS_DECG); bf16_t* MIX = (bf16_t*)(p->ws + WS_MIX);
    LAS unsigned char* raw_ = lds + MX_RAW;
    LAS unsigned char* outI_ = lds + MX_OUT;
    LAS float* dec_ = (LAS float*)(lds + MX_AUX);
    LAS float* rsq = dec_ + 128;
    LAS float* gnS = rsq + 512;
    const int hl = w >> 2, ps = (w & 3) * 32, lh = lane >> 5, l31 = lane & 31;
    const int prow_ = tid >> 3, c7_ = tid & 7;
    if (tid < 256) gnS[tid] = p->in[7][256 * hp + tid];
    f32x16 S[2];
#pragma unroll
    for (int mt = 0; mt < 2; ++mt)
#pragma unroll
        for (int r = 0; r < 16; ++r) S[mt][r] = 0.f;
    u32x4 pf[12]; float pfd = 0.f;
#define GLA_FETCH(cc) do { const size_t rw_ = (size_t)b * LP + 64 * (cc) + prow; const bf16_t* rp = PROJ + rw_ * LDP + 8 * c7; const bf16_t* kp_ = KD + rw_ * 256 + 128 * hp + 8 * c7; \
        _Pragma("unroll") for (int k = 0; k < 12; ++k) { \
            if (k == 2 || k == 3) pf[k] = *(const u32x4*)(kp_ + 64 * (k - 2)); \
            else { const int col = k < 2 ? C_Q + 128 * hp + 64 * k : (k < 8 ? C_V + 256 * hp + 64 * (k - 4) : C_OG + 256 * hp + 64 * (k - 8)); pf[k] = *(const u32x4*)(rp + col); } } \
        if (tid < 128) pfd = DECG[((size_t)b * NCH + (cc)) * 256 + 128 * hp + tid]; } while (0)
    { const int prow = prow_, c7 = c7_; GLA_FETCH(0); }
    for (int c = 0; c < NCH; ++c) {
        int oz = 0; asm volatile("" : "+v"(oz));
        LAS unsigned char* const raw = raw_ + oz; LAS unsigned char* const outI = outI_ + oz; LAS float* const dec = dec_ + oz;
        const int prow = prow_ + oz, c7 = c7_ + oz;
        if (c >= 2) { bf16_t* dst = MIX + ((size_t)b * SEQ + 64 * (c - 2) + prow) * D + 256 * hp;
#pragma unroll
            for (int k = 0; k < 4; ++k) { const int ch = 8 * k + c7; *(u32x4*)(dst + 8 * ch) = *(const LAS u32x4*)(outI + 512 * prow + 16 * (ch ^ swz(prow))); } }
#pragma unroll
        for (int k = 0; k < 12; ++k) *(LAS u32x4*)(raw + 1536 * prow + 16 * ((8 * k + c7) ^ swz(prow))) = pf[k];
        if (tid < 128) dec[tid] = pfd;
        __syncthreads();
        if (c + 1 < NCH) GLA_FETCH(c + 1);
#pragma unroll
        for (int mt = 0; mt < 2; ++mt)
#pragma unroll
            for (int r = 0; r < 16; ++r) S[mt][r] *= dec[hl * 64 + 32 * mt + crow(r, lh)];
#pragma unroll
        for (int ks = 0; ks < 4; ++ks) {
            const bf16x8 bv = tr_frag<1536>(raw, 256 + 128 * hl + ps, ks, lane);
#pragma unroll
            for (int mt = 0; mt < 2; ++mt) { const bf16x8 av = tr_frag<1536>(raw, 128 + 64 * hl + 32 * mt, ks, lane); S[mt] = mfma32(av, bv, S[mt]); }
            __builtin_amdgcn_sched_barrier(0);
        }
        if (c > 0) {
            f32x16 Z[2];
#pragma unroll
            for (int mt = 0; mt < 2; ++mt)
#pragma unroll
                for (int r = 0; r < 16; ++r) Z[mt][r] = 0.f;
#pragma unroll
            for (int ms = 0; ms < 2; ++ms)
#pragma unroll
                for (int s = 0; s < 2; ++s) {
                    const bf16x8 av = PACK8(S[ms], s);
#pragma unroll
                    for (int mt = 0; mt < 2; ++mt) { const bf16x8 bv = rowp_frag<1536>(raw, 32 * mt + l31, 64 * hl + 32 * ms + 16 * s + 4 * lh); Z[mt] = mfma32(av, bv, Z[mt]); }
                    __builtin_amdgcn_sched_barrier(0);
                }
#pragma unroll
            for (int mt = 0; mt < 2; ++mt) { float ssq = 0.f;
#pragma unroll
                for (int r = 0; r < 16; ++r) ssq += Z[mt][r] * Z[mt][r];
                ssq += __shfl_xor(ssq, 32);
                if (lh == 0) rsq[(hl * 4 + (w & 3)) * 64 + 32 * mt + l31] = ssq * (0.125f * 0.125f); }
            __syncthreads();
#pragma unroll
            for (int mt = 0; mt < 2; ++mt) { const int i = 32 * mt + l31;
                const float tot = (rsq[(hl * 4 + 0) * 64 + i] + rsq[(hl * 4 + 1) * 64 + i]) + (rsq[(hl * 4 + 2) * 64 + i] + rsq[(hl * 4 + 3) * 64 + i]);
                const float rn = 0.125f * fast_rsq(tot * (1.0f / 128.0f) + RMS_EPS);
#pragma unroll
                for (int g4 = 0; g4 < 4; ++g4) { const int p0 = 128 * hl + ps + 8 * g4 + 4 * lh;
                    const u32x2 og2 = *(const LAS u32x2*)(raw + img_off<1536>(i, 512 + p0));
                    const f32x4 gv = *(const LAS f32x4*)(gnS + p0);
                    u32x2 o2;
                    const f32x2_t rn2 = {rn, rn};
                    const f32x2_t q0 = (f32x2_t){Z[mt][4 * g4 + 0], Z[mt][4 * g4 + 1]} * rn2 * (f32x2_t){gv.x, gv.y} * silu_f2(bf2f2(og2.x));
                    const f32x2_t q1 = (f32x2_t){Z[mt][4 * g4 + 2], Z[mt][4 * g4 + 3]} * rn2 * (f32x2_t){gv.z, gv.w} * silu_f2(bf2f2(og2.y));
                    o2.x = cvt_pk_bf16(q0.x, q0.y); o2.y = cvt_pk_bf16(q1.x, q1.y);
                    *(LAS u32x2*)(outI + img_off<512>(i, p0)) = o2; } }
        }
        __syncthreads();
    }
    { const int t2 = opaque_tid(); const int prow = t2 >> 3, c7 = t2 & 7; LAS unsigned char* const outI = outI_;
      bf16_t* dst = MIX + ((size_t)b * SEQ + 64 * (NCH - 2) + prow) * D + 256 * hp;
#pragma unroll
      for (int k = 0; k < 4; ++k) { const int ch = 8 * k + c7; *(u32x4*)(dst + 8 * ch) = *(const LAS u32x4*)(outI + 512 * prow + 16 * (ch ^ swz(prow))); } }
#undef GLA_FETCH
}

__device__ __forceinline__ void ssd_unit(LAS unsigned char* lds, int b, int g, int par) {
    const KP p = kparams();
    const int tid = opaque_tid(), lane = tid & 63, w = __builtin_amdgcn_readfirstlane(tid >> 6);
    const bf16_t* PROJ = (const bf16_t*)(p->ws + WS_PROJ); const bf16_t* XA = (const bf16_t*)(p->ws + WS_XA); const bf16_t* XW = (const bf16_t*)(p->ws + WS_XW);
    const float* DECS = (const float*)(p->ws + WS_DECS); bf16_t* MIX = (bf16_t*)(p->ws + WS_MIX);
    LAS unsigned char* raw_ = lds + MX_RAW;
    LAS unsigned char* xw_ = lds + MX_OUT;
    LAS float* decS_ = (LAS float*)(lds + MX_AUX);
    LAS float* rsq = decS_ + 16;
    LAS float* ngS = rsq + 512;
    const int hl = w >> 1, ps = (w & 1) * 32, lh = lane >> 5, l31 = lane & 31;
    const int hh = 4 * g + hl;
    const int prow_ = tid >> 3, c7_ = tid & 7;
    const float Dp = p->in[12][hh];
    if (tid < 256) ngS[tid] = p->in[13][256 * g + tid];
    f32x16 S[4];
#pragma unroll
    for (int mt = 0; mt < 4; ++mt)
#pragma unroll
        for (int r = 0; r < 16; ++r) S[mt][r] = 0.f;
    u32x4 pf[12], pw[4]; float pfd = 0.f;
#define SSD_FETCH(cc) do { const size_t rw_ = (size_t)b * LP + 64 * (cc) + prow; const bf16_t* xa = XA + rw_ * 1024 + 8 * c7; const bf16_t* zp = PROJ + rw_ * LDP + 8 * c7 + C_Z + 256 * g; const bf16_t* xq = XW + rw_ * 512 + 256 * g + 8 * c7; \
        pf[4] = *(const u32x4*)(xa + 512 + 128 * g); pf[5] = *(const u32x4*)(xa + 512 + 128 * g + 64); \
        _Pragma("unroll") for (int k = 0; k < 4; ++k) pw[k] = *(const u32x4*)(xq + 64 * k); \
        if ((cc) > 0 && (((cc) & 1) == par)) {                         \
            _Pragma("unroll") for (int k = 0; k < 4; ++k) pf[k] = *(const u32x4*)(xa + 256 * g + 64 * k); \
            pf[6] = *(const u32x4*)(xa + 768 + 128 * g); pf[7] = *(const u32x4*)(xa + 768 + 128 * g + 64); \
            _Pragma("unroll") for (int k = 0; k < 4; ++k) pf[8 + k] = *(const u32x4*)(zp + 64 * k); } \
        if (tid < 4) pfd = DECS[((size_t)b * NCH + (cc)) * 8 + 4 * g + tid]; } while (0)
    { const int prow = prow_, c7 = c7_; SSD_FETCH(0); }
    for (int c = 0; c < NCH; ++c) {
        int oz = 0; asm volatile("" : "+v"(oz));
        LAS unsigned char* const raw = raw_ + oz; LAS unsigned char* const xw = xw_ + oz; LAS float* const decS = decS_ + oz;
        const int prow = prow_ + oz, c7 = c7_ + oz;
        const bool dout = c > 0 && ((c & 1) == par);
        if (c >= 2 && !dout) { bf16_t* dst = MIX + ((size_t)b * SEQ + 64 * (c - 2) + prow) * D + 512 + 256 * g;
#pragma unroll
            for (int k = 0; k < 4; ++k) { const int ch = 8 * k + c7; *(u32x4*)(dst + 8 * ch) = *(const LAS u32x4*)(xw + 512 * prow + 16 * (ch ^ swz(prow))); } }
#pragma unroll
        for (int k = 0; k < 12; ++k) *(LAS u32x4*)(raw + 1536 * prow + 16 * ((8 * k + c7) ^ swz(prow))) = pf[k];
#pragma unroll
        for (int k = 0; k < 4; ++k) *(LAS u32x4*)(xw + 512 * prow + 16 * ((8 * k + c7) ^ swz(prow))) = pw[k];
        if (tid < 4) decS[tid] = pfd;
        __syncthreads();
        if (c + 1 < NCH) SSD_FETCH(c + 1);
        { const float dc = decS[hl];
#pragma unroll
          for (int mt = 0; mt < 4; ++mt)
#pragma unroll
              for (int r = 0; r < 16; ++r) S[mt][r] *= dc; }
#pragma unroll
        for (int ks = 0; ks < 4; ++ks) {
            const bf16x8 bv = tr_frag<512>(xw, 64 * hl + ps, ks, lane);
#pragma unroll
            for (int mt = 0; mt < 4; ++mt) { const bf16x8 av = tr_frag<1536>(raw, 256 + 32 * mt, ks, lane); S[mt] = mfma32(av, bv, S[mt]); }
            __builtin_amdgcn_sched_barrier(0);
        }
        if (dout) {
            f32x16 Y[2];
#pragma unroll
            for (int mt = 0; mt < 2; ++mt)
#pragma unroll
                for (int r = 0; r < 16; ++r) Y[mt][r] = 0.f;
#pragma unroll
            for (int ms = 0; ms < 4; ++ms)
#pragma unroll
                for (int s = 0; s < 2; ++s) {
                    const bf16x8 av = PACK8(S[ms], s);
#pragma unroll
                    for (int mt = 0; mt < 2; ++mt) { const bf16x8 bv = rowp_frag<1536>(raw, 32 * mt + l31, 384 + 32 * ms + 16 * s + 4 * lh); Y[mt] = mfma32(av, bv, Y[mt]); }
                    __builtin_amdgcn_sched_barrier(0);
                }
#pragma unroll
            for (int mt = 0; mt < 2; ++mt) { const int i = 32 * mt + l31; float ssq = 0.f;
#pragma unroll
                for (int g4 = 0; g4 < 4; ++g4) { const int p0 = 64 * hl + ps + 8 * g4 + 4 * lh;
                    const u32x2 x2 = *(const LAS u32x2*)(raw + img_off<1536>(i, p0)), z2 = *(const LAS u32x2*)(raw + img_off<1536>(i, 512 + p0));
                    const f32x2_t Dp2 = {Dp, Dp};
                    const f32x2_t w01 = ((f32x2_t){Y[mt][4 * g4 + 0], Y[mt][4 * g4 + 1]} + bf2f2(x2.x) * Dp2) * silu_f2(bf2f2(z2.x));
                    const f32x2_t w23 = ((f32x2_t){Y[mt][4 * g4 + 2], Y[mt][4 * g4 + 3]} + bf2f2(x2.y) * Dp2) * silu_f2(bf2f2(z2.y));
                    const float v0 = w01.x, v1 = w01.y, v2 = w23.x, v3 = w23.y;
                    Y[mt][4 * g4 + 0] = v0; Y[mt][4 * g4 + 1] = v1; Y[mt][4 * g4 + 2] = v2; Y[mt][4 * g4 + 3] = v3;
                    ssq += (v0 * v0 + v1 * v1) + (v2 * v2 + v3 * v3); }
                ssq += __shfl_xor(ssq, 32);
                if (lh == 0) rsq[w * 64 + i] = ssq; }
            __syncthreads();
#pragma unroll
            for (int mt = 0; mt < 2; ++mt) { const int i = 32 * mt + l31;
                float tot = 0.f;
#pragma unroll
                for (int ww = 0; ww < 8; ++ww) tot += rsq[ww * 64 + i];
                const float rn = fast_rsq(tot * (1.0f / 256.0f) + RMS_EPS);
#pragma unroll
                for (int g4 = 0; g4 < 4; ++g4) { const int p0 = 64 * hl + ps + 8 * g4 + 4 * lh;
                    const f32x4 gv = *(const LAS f32x4*)(ngS + p0);
                    u32x2 o2; o2.x = cvt_pk_bf16(Y[mt][4 * g4 + 0] * rn * gv.x, Y[mt][4 * g4 + 1] * rn * gv.y); o2.y = cvt_pk_bf16(Y[mt][4 * g4 + 2] * rn * gv.z, Y[mt][4 * g4 + 3] * rn * gv.w);
                    *(LAS u32x2*)(xw + img_off<512>(i, p0)) = o2; } }
        }
        __syncthreads();
    }
    if (((NCH - 1) & 1) == par) { const int t2 = opaque_tid(); const int prow = t2 >> 3, c7 = t2 & 7; LAS unsigned char* const xw = xw_;
      bf16_t* dst = MIX + ((size_t)b * SEQ + 64 * (NCH - 2) + prow) * D + 512 + 256 * g;
#pragma unroll
      for (int k = 0; k < 4; ++k) { const int ch = 8 * k + c7; *(u32x4*)(dst + 8 * ch) = *(const LAS u32x4*)(xw + 512 * prow + 16 * (ch ^ swz(prow))); } }
#undef SSD_FETCH
}
constexpr int CW_QUEUE = 64;
__device__ __forceinline__ void convert_batches(LAS unsigned char* lds, int maxb, unsigned per) {
    const KP p = kparams();
    const int tid = opaque_tid(), lane = tid & 63, wave = __builtin_amdgcn_readfirstlane(tid >> 6);
    LAS float* scr = (LAS float*)(lds + wave * 16384);
    unsigned char* WguT = (unsigned char*)p->out + OUT_WGU; unsigned char* WdT = (unsigned char*)p->out + OUT_WD;
    unsigned* qhead = (unsigned*)(p->ws + WS_CTL) + CW_QUEUE;
    constexpr int I_EXP = 16 * 32, NITEMS = 3 * NE * I_EXP;
    for (int vb = 0; vb != maxb; ++vb) {
        unsigned it0 = 0; if (lane == 0) it0 = __hip_atomic_fetch_add(qhead, per, __ATOMIC_RELAXED, __HIP_MEMORY_SCOPE_AGENT);
        const int r0 = __builtin_amdgcn_readfirstlane((int)it0);
        if (r0 >= NITEMS) break;
        for (int q = 0; q < (int)per; ++q) {
            int r = r0 + q;
            if (r >= NITEMS) break;
            const int which = r / (NE * I_EXP); r %= (NE * I_EXP);
            const int e = r / I_EXP; r %= I_EXP; const int kb = r % 16, nb = r / 16, n0 = 32 * nb;
            if (which == 0) transpose_item_f6(p->in[19] + (size_t)e * D * D, D, 64 * kb, n0, WguT + (size_t)e * 2048 * W8_PITCH, 256 * (n0 >> 7) + 64 * ((n0 & 127) >> 5), scr, lane, W8_SCALE);
            else if (which == 1) transpose_item_f6(p->in[20] + (size_t)e * D * D, D, 64 * kb, n0, WguT + (size_t)e * 2048 * W8_PITCH, 256 * (n0 >> 7) + 64 * ((n0 & 127) >> 5) + 32, scr, lane, W8_SCALE);
            else transpose_item_f6(p->in[23] + (size_t)e * D * D, D, 64 * kb, n0, WdT + (size_t)e * D * W8_PITCH, n0, scr, lane, WD6_SCALE);
        }
    }
}
__device__ __forceinline__ void phase_mixer(LAS unsigned char* lds, int bx, int G) {
    for (int u = bx; u < 192; u += G) {
        if (u < 128) ssd_unit(lds, u >> 2, (u >> 1) & 1, u & 1);
        else gla_unit(lds, (u - 128) >> 1, (u - 128) & 1);
        __syncthreads();
    }
    convert_batches(lds, -1, 8u);
}

__device__ __forceinline__ void phase_ln1_router(LAS unsigned char* lds, int vcu, int G) {
    const KP p = kparams();
    const int tid = opaque_tid(), lane = tid & 63, w = __builtin_amdgcn_readfirstlane(tid >> 6);
    const bf16_t* V1 = (const bf16_t*)(p->ws + WS_V1); unsigned char* H1Q = p->ws + WS_H1Q;
    int* cnt = (int*)(p->ws + WS_CTL); int* tlist = (int*)(p->ws + WS_TLIST); int* tokslot = (int*)(p->ws + WS_TOKSLOT); float* tokgate = (float*)(p->ws + WS_TOKGATE);
    LAS float* rwS = (LAS float*)lds;
    LAS unsigned char* stg = lds + 65536 + w * 4608;
    LAS float* stat = (LAS float*)(lds + 65536 + 8 * 4608) + w * 64;
    LAS int* lcnt = (LAS int*)(lds + 131072);
    LAS int* gbase = lcnt + 32;
    LAS int* rec_e = gbase + 32;
    LAS int* rec_pos = rec_e + 1024;
    LAS float* rec_g = (LAS float*)(rec_pos + 1024);
    const int i = lane & 31, kk = lane >> 5; const unsigned kmask = 0u - (unsigned)kk;
    const float rb = p->in[18][i];
    const float* g1 = p->in[15]; const float* b1 = p->in[16];
    f32x4 gg[4], bb[4];
#pragma unroll
    for (int j = 0; j < 4; ++j) { gg[j] = ((const f32x4*)g1)[2 * lane + (j & 1) + 128 * (j >> 1)]; bb[j] = ((const f32x4*)b1)[2 * lane + (j & 1) + 128 * (j >> 1)]; }
    for (int blk = vcu; blk < NTOK / 256; blk += G) {
        if (tid < 32) lcnt[tid] = 0;
        const size_t row0 = (size_t)blk * 256 + w * 32;
        u32x4 xn[2][2];
#pragma unroll
        for (int q = 0; q < 2; ++q) { const u32x4* vp = (const u32x4*)(V1 + (row0 + q) * D); xn[q][0] = vp[lane]; xn[q][1] = vp[64 + lane]; }
#pragma unroll 1
        for (int rr = 0; rr < 32; rr += 2) {
            u32x4 xr[2][2];
#pragma unroll
            for (int q = 0; q < 2; ++q) { xr[q][0] = xn[q][0]; xr[q][1] = xn[q][1]; }
            if (rr + 2 < 32) {
#pragma unroll
                for (int q = 0; q < 2; ++q) { const u32x4* vp = (const u32x4*)(V1 + (row0 + rr + 2 + q) * D); xn[q][0] = vp[lane]; xn[q][1] = vp[64 + lane]; } }
#pragma unroll
            for (int q = 0; q < 2; ++q) {
                f32x4 v[4];
#pragma unroll
                for (int c = 0; c < 2; ++c) { const u32x4 x = xr[q][c];
                    v[2 * c] = (f32x4){bf2f(x.x & 0xffffu), bf2f(x.x >> 16), bf2f(x.y & 0xffffu), bf2f(x.y >> 16)}; v[2 * c + 1] = (f32x4){bf2f(x.z & 0xffffu), bf2f(x.z >> 16), bf2f(x.w & 0xffffu), bf2f(x.w >> 16)}; }
                float s = 0.f, s2 = 0.f;
#pragma unroll
                for (int j = 0; j < 4; ++j) { s += (v[j].x + v[j].y) + (v[j].z + v[j].w); s2 += (v[j].x * v[j].x + v[j].y * v[j].y) + (v[j].z * v[j].z + v[j].w * v[j].w); }
                s = wave_sum(s); s2 = wave_sum(s2);
                const float mean = s * (1.f / D), rstd = fast_rsq(fmaxf(s2 * (1.f / D) - mean * mean, 0.f) + LN_EPS);
                if (lane == 0) { stat[2 * (rr + q)] = mean; stat[2 * (rr + q) + 1] = rstd; }
                const size_t row = row0 + rr + q;
                u32x4 o[2];
#pragma unroll
                for (int c = 0; c < 2; ++c) { const f32x4 a = (v[2 * c] - mean) * rstd * gg[2 * c] + bb[2 * c], b = (v[2 * c + 1] - mean) * rstd * gg[2 * c + 1] + bb[2 * c + 1];
                    o[c].x = cvt_pk_bf16(a.x, a.y); o[c].y = cvt_pk_bf16(a.z, a.w); o[c].z = cvt_pk_bf16(b.x, b.y); o[c].w = cvt_pk_bf16(b.z, b.w); }
#pragma unroll
                for (int c = 0; c < 2; ++c) { const u32x4 o2 = o[c] + 0x00800080u; u32x16 blk;
#pragma unroll
                    for (int d = 0; d < 4; ++d) { blk[d] = (unsigned)__builtin_amdgcn_mov_dpp((int)o2[d], 0x00, 0xf, 0xf, false); blk[4 + d] = (unsigned)__builtin_amdgcn_mov_dpp((int)o2[d], 0x55, 0xf, 0xf, false);
                        blk[8 + d] = (unsigned)__builtin_amdgcn_mov_dpp((int)o2[d], 0xaa, 0xf, 0xf, false); blk[12 + d] = (unsigned)__builtin_amdgcn_mov_dpp((int)o2[d], 0xff, 0xf, 0xf, false); }
                    const u32x6 r6 = cvt_fp6x32(blk);
                    const int kb = (lane >> 2) + 16 * c; unsigned char* slot = H1Q + row * D + 128 * (kb >> 2); const int g = kb & 3;
                    if ((lane & 3) == 0) *(u32x4*)(slot + 16 * g) = (u32x4){r6[0], r6[1], r6[2], r6[3]};
                    if ((lane & 3) == 1) *(u32x2*)(slot + 64 + 8 * g) = (u32x2){r6[4], r6[5]}; }
            }
        }
        const float mean = stat[2 * i], rstd = stat[2 * i + 1];
        f32x16 acc;
#pragma unroll
        for (int r = 0; r < 16; ++r) acc[r] = 0.f;
        u32x4 tn[4];
#pragma unroll
        for (int q = 0; q < 4; ++q) tn[q] = *(const u32x4*)(V1 + (row0 + 8 * q + (lane >> 3)) * D + 8 * (lane & 7));
        for (int kh = 0; kh < 2; ++kh) {
            __syncthreads();
            for (int idx = tid; idx < 16384; idx += NTHREADS) rwS[idx] = p->in[17][kh * 16384 + idx];
            __syncthreads();
#pragma unroll 1
            for (int kc = 0; kc < 8; ++kc) {
                const int k0 = 512 * kh + 64 * kc;
#pragma unroll
                for (int q = 0; q < 4; ++q) { const int r8 = 8 * q + (lane >> 3); *(LAS u32x4*)(stg + 144 * r8 + 16 * (lane & 7)) = tn[q]; }
                if (k0 + 64 < D) {
#pragma unroll
                    for (int q = 0; q < 4; ++q) tn[q] = *(const u32x4*)(V1 + (row0 + 8 * q + (lane >> 3)) * D + k0 + 64 + 8 * (lane & 7)); }
#pragma unroll
                for (int c8 = 0; c8 < 8; ++c8) {
                    const u32x4 x = *(const LAS u32x4*)(stg + 144 * i + 16 * c8);
                    const int kb = k0 + 8 * c8;
                    float hn[8];
                    hn[0] = (bf2f(x.x & 0xffffu) - mean) * rstd * g1[kb + 0] + b1[kb + 0]; hn[1] = (bf2f(x.x >> 16) - mean) * rstd * g1[kb + 1] + b1[kb + 1];
                    hn[2] = (bf2f(x.y & 0xffffu) - mean) * rstd * g1[kb + 2] + b1[kb + 2]; hn[3] = (bf2f(x.y >> 16) - mean) * rstd * g1[kb + 3] + b1[kb + 3];
                    hn[4] = (bf2f(x.z & 0xffffu) - mean) * rstd * g1[kb + 4] + b1[kb + 4]; hn[5] = (bf2f(x.z >> 16) - mean) * rstd * g1[kb + 5] + b1[kb + 5];
                    hn[6] = (bf2f(x.w & 0xffffu) - mean) * rstd * g1[kb + 6] + b1[kb + 6]; hn[7] = (bf2f(x.w >> 16) - mean) * rstd * g1[kb + 7] + b1[kb + 7];
                    const LAS float* bp = rwS + (64 * kc + 8 * c8 + kk) * 32 + i;
#pragma unroll
                    for (int s4 = 0; s4 < 4; ++s4) { const float a = __uint_as_float((__float_as_uint(hn[2 * s4]) & ~kmask) | (__float_as_uint(hn[2 * s4 + 1]) & kmask));
                        acc = __builtin_amdgcn_mfma_f32_32x32x2f32(a, bp[64 * s4], acc, 0, 0, 0); }
                }
            }
        }
#pragma unroll
        for (int reg = 0; reg < 16; ++reg) {
            float lv = acc[reg] + rb; const int rl = w * 32 + crow(reg, kk);
            float tv[4]; int te[4];
#pragma unroll
            for (int k = 0; k < 4; ++k) {
                float bvv = lv; int bi = i;
#pragma unroll
                for (int o = 1; o < 32; o <<= 1) { const float ov = __shfl_xor(bvv, o); const int oi = __shfl_xor(bi, o); if (ov > bvv || (ov == bvv && oi < bi)) { bvv = ov; bi = oi; } }
                tv[k] = bvv; te[k] = bi; if (i == bi) lv = -3.0e38f;
            }
            const float e1 = __expf(tv[1] - tv[0]), e2 = __expf(tv[2] - tv[0]), e3 = __expf(tv[3] - tv[0]); const float inv = 1.f / (1.f + e1 + e2 + e3);
            if (i < 4) { const int ek = i == 0 ? te[0] : (i == 1 ? te[1] : (i == 2 ? te[2] : te[3]));
                const float gk = (i == 0 ? 1.f : (i == 1 ? e1 : (i == 2 ? e2 : e3))) * inv;
                const int pos = atomicAdd((int*)&lcnt[ek], 1);
                rec_e[rl * 4 + i] = ek; rec_pos[rl * 4 + i] = pos; rec_g[rl * 4 + i] = gk; }
        }
        __syncthreads();
        if (tid < 32) gbase[tid] = atomicAdd(&cnt[tid], lcnt[tid]);
        __syncthreads();
        for (int r2 = tid; r2 < 1024; r2 += NTHREADS) { const int e = rec_e[r2], gp = gbase[e] + rec_pos[r2]; const int tok = blk * 256 + (r2 >> 2);
            tlist[e * NTOK + gp] = tok; tokslot[tok * 4 + (r2 & 3)] = (e << 20) | gp; tokgate[tok * 4 + (r2 & 3)] = rec_g[r2]; }
        __syncthreads();
    }
}

__device__ __forceinline__ bool moe_plan(const int* cnt, int pass, int& e0, int& e1, int& ybase0) {
    int tb = 0; for (int e = 0; e < NE; ++e) tb += (cnt[e] + 255) >> 8;
    const int npass = (tb + HID_CAP_BLOCKS - 1) / HID_CAP_BLOCKS, target = (tb + npass - 1) / (npass > 0 ? npass : 1);
    int e = 0, yb = 0;
    for (int ps = 0; e < NE; ++ps) {
        int acc = 0; const int es = e, ybs = yb;
        while (e < NE) { const int nrb = (cnt[e] + 255) >> 8; if (acc > 0 && (acc + nrb > HID_CAP_BLOCKS || acc >= target)) break; acc += nrb; yb += nrb * 256; ++e; }
        if (ps == pass) { e0 = es; e1 = e; ybase0 = ybs; return true; }
    }
    return false;
}
__device__ __forceinline__ void phase_moe_gemm(LAS unsigned char* lds, int G, int c, int pass, bool second) {
    const KP p = kparams();
    const int* cnt = (const int*)(p->ws + WS_CTL);
    (void)pass; const int e0 = 0, e1 = NE, yb0 = 0;
    gm::MoeSched S; S.cnt = cnt; S.e0 = e0; S.e1 = e1; S.G = G; S.c = c; S.ybase0 = yb0; S.second = second; S.npn = second ? 4 : 8; S.reset();
    const bf16_t* WguT = (const bf16_t*)((unsigned char*)p->out + OUT_WGU); const bf16_t* WdT = (const bf16_t*)((unsigned char*)p->out + OUT_WD);
    unsigned char* HID = p->ws + WS_HID; unsigned char* Y = p->ws + WS_Y;
    if (!second) { gm::EpiSwiglu E{HID, p->in[21], p->in[22]};
        gm::gemm_phase<gm::EpiSwiglu, gm::MoeSched, true, true, true>(lds, (const bf16_t*)(p->ws + WS_H1Q), WguT, (size_t)2048 * W8_PITCH, (const int*)(p->ws + WS_TLIST), S, E); }
    else { gm::EpiDown E{Y, p->in[24]};
        gm::gemm_phase<gm::EpiDown, gm::MoeSched, false, true, false, true>(lds, (const bf16_t*)HID, WdT, (size_t)D * W8_PITCH, nullptr, S, E); }
}
__device__ __forceinline__ void phase_combine(LAS unsigned char* lds, int vcu, int G) {
    const KP p = kparams();
    const int tid = opaque_tid(), lane = tid & 63, w = __builtin_amdgcn_readfirstlane(tid >> 6);
    const int* cnt = (const int*)(p->ws + WS_CTL); const int* tokslot = (const int*)(p->ws + WS_TOKSLOT); const float* tokgate = (const float*)(p->ws + WS_TOKGATE);
    const bf16_t* V1 = (const bf16_t*)(p->ws + WS_V1); const unsigned char* Y = p->ws + WS_Y;
    LAS int* ybase = (LAS int*)lds;
    if (tid < 64) { int a = tid < NE ? ((cnt[tid] + 255) >> 8) * 256 : 0; const int own = a;
#pragma unroll
        for (int o = 1; o < 32; o <<= 1) { const int t = __shfl_up(a, o); if (lane >= o) a += t; }
        if (tid < NE) ybase[tid] = a - own; }
    __syncthreads();
    const int gw = vcu * NWAVES + w, NGW = G * NWAVES;
    f32x4 g2[4], b2[4];
#pragma unroll
    for (int j = 0; j < 4; ++j) { g2[j] = ((const f32x4*)p->in[25])[2 * lane + (j & 1) + 128 * (j >> 1)]; b2[j] = ((const f32x4*)p->in[26])[2 * lane + (j & 1) + 128 * (j >> 1)]; }
    f32x4 g1[4], b1[4];
#pragma unroll
    for (int j = 0; j < 4; ++j) { g1[j] = ((const f32x4*)p->in[15])[2 * lane + (j & 1) + 128 * (j >> 1)] * ALPHA; b1[j] = ((const f32x4*)p->in[16])[2 * lane + (j & 1) + 128 * (j >> 1)] * ALPHA; }
    for (int t0 = 2 * gw; t0 < NTOK; t0 += 2 * NGW) {
        u32x4 hr[2][2]; u32x2 yr[2][4][2]; float gk[2][4];
#pragma unroll
        for (int r = 0; r < 2; ++r) { const int t = t0 + r;
            const u32x4* hp = (const u32x4*)(V1 + (size_t)t * D); hr[r][0] = hp[lane]; hr[r][1] = hp[64 + lane];
#pragma unroll
            for (int k = 0; k < 4; ++k) { const int sl = tokslot[t * 4 + k]; gk[r][k] = tokgate[t * 4 + k];
                const u32x2* yp = (const u32x2*)(Y + (size_t)(ybase[sl >> 20] + (sl & 0xfffff)) * D); yr[r][k][0] = yp[lane]; yr[r][k][1] = yp[64 + lane]; } }
#pragma unroll
        for (int r = 0; r < 2; ++r) {
            f32x4 v[4];
#pragma unroll
            for (int c = 0; c < 2; ++c) { const u32x4 x = hr[r][c];
                v[2 * c] = (f32x4){bf2f(x.x & 0xffffu), bf2f(x.x >> 16), bf2f(x.y & 0xffffu), bf2f(x.y >> 16)};
                v[2 * c + 1] = (f32x4){bf2f(x.z & 0xffffu), bf2f(x.z >> 16), bf2f(x.w & 0xffffu), bf2f(x.w >> 16)}; }
            { float s1 = 0.f, q1 = 0.f;
#pragma unroll
              for (int j = 0; j < 4; ++j) { s1 += (v[j].x + v[j].y) + (v[j].z + v[j].w); q1 += (v[j].x * v[j].x + v[j].y * v[j].y) + (v[j].z * v[j].z + v[j].w * v[j].w); }
              s1 = wave_sum(s1); q1 = wave_sum(q1);
              const float mean1 = s1 * (1.f / D), rstd1 = fast_rsq(fmaxf(q1 * (1.f / D) - mean1 * mean1, 0.f) + LN_EPS);
#pragma unroll
              for (int j = 0; j < 4; ++j) v[j] = (v[j] - mean1) * rstd1 * g1[j] + b1[j]; }
#pragma unroll
            for (int k = 0; k < 4; ++k)
#pragma unroll
                for (int c = 0; c < 2; ++c) { const u32x2 x = yr[r][k][c]; const float g = gk[r][k] * (1.0f / Y8_SCALE);
                    const f32x2_t a0 = __builtin_amdgcn_cvt_pk_f32_fp8((int)x.x, false), a1 = __builtin_amdgcn_cvt_pk_f32_fp8((int)x.x, true);
                    const f32x2_t a2 = __builtin_amdgcn_cvt_pk_f32_fp8((int)x.y, false), a3 = __builtin_amdgcn_cvt_pk_f32_fp8((int)x.y, true);
                    v[2 * c] += (f32x4){a0.x, a0.y, a1.x, a1.y} * g;
                    v[2 * c + 1] += (f32x4){a2.x, a2.y, a3.x, a3.y} * g; }
            float s = 0.f;
#pragma unroll
            for (int j = 0; j < 4; ++j) s += (v[j].x + v[j].y) + (v[j].z + v[j].w);
            const float mean = wave_sum(s) * (1.f / D); float s2 = 0.f;
#pragma unroll
            for (int j = 0; j < 4; ++j) { v[j] = v[j] - mean; s2 += (v[j].x * v[j].x + v[j].y * v[j].y) + (v[j].z * v[j].z + v[j].w * v[j].w); }
            const float rstd = fast_rsq(wave_sum(s2) * (1.f / D) + LN_EPS);
            f32x4* op = (f32x4*)(p->out + (size_t)(t0 + r) * D);
#pragma unroll
            for (int j = 0; j < 4; ++j) op[2 * lane + (j & 1) + 128 * (j >> 1)] = v[j] * rstd * g2[j] + b2[j];
        }
    }
}

#define XB_TMO      128
#define XB_XCNT(j)  (256  + 64 * (j))
#define XB_XSUB(j)  (1280 + 64 * (j))
#define XB_XGEN(j)  (2304 + 64 * (j))
#define XB_TOP      3328
#define XB_TOPGEN   3392
#define XCD_BAR_WORDS 3456
#define XB_SPIN_CAP (1u << 22)
constexpr int CW_BAR = 4096;
__device__ __forceinline__ unsigned xb_ld(unsigned* p)              { return __hip_atomic_load(p, __ATOMIC_RELAXED, __HIP_MEMORY_SCOPE_AGENT); }
__device__ __forceinline__ unsigned xb_add(unsigned* p, unsigned v) { return __hip_atomic_fetch_add(p, v, __ATOMIC_RELAXED, __HIP_MEMORY_SCOPE_AGENT); }
__device__ __forceinline__ unsigned xb_xcc_id() { return (unsigned)__builtin_amdgcn_s_getreg((3 << 11) | 20) & 0xFu; }
#define XB_SPIN(cond, bar) do { unsigned _sp = 0; while (cond) { __builtin_amdgcn_s_sleep(1); \
    if ((++_sp & 255u) == 0u) { if (xb_ld(&(bar)[XB_TMO])) break; if (_sp > XB_SPIN_CAP) { atomicAdd(&(bar)[XB_TMO], 1u); break; } } } } while (0)
struct XcdBarrier { unsigned* bar; unsigned x; volatile LAS unsigned* st; };
__device__ __forceinline__ XcdBarrier xcd_barrier_post(unsigned* bar, volatile LAS unsigned* st) {
    XcdBarrier b; b.bar = bar; b.x = xb_xcc_id(); b.st = st;
    if (threadIdx.x == 0) (void)xb_add(&bar[XB_XCNT(b.x)], 1u);
    return b;
}
__device__ __forceinline__ void xcd_barrier_complete(unsigned* bar, unsigned x, unsigned& nloc, unsigned& nx) {
    const unsigned G = gridDim.x * gridDim.y * gridDim.z;
    unsigned sum, cnt, mine, sp = 0u;
    for (;;) {
        sum = 0u; cnt = 0u; mine = 0u;
#pragma unroll
        for (unsigned j = 0; j < 16; ++j) { const unsigned c = xb_ld(&bar[XB_XCNT(j)]); sum += c; cnt += (c > 0u) ? 1u : 0u; mine = (j == x) ? c : mine; }
        if (sum == G) break;
        __builtin_amdgcn_s_sleep(1);
        if ((++sp & 255u) == 0u) { if (xb_ld(&bar[XB_TMO])) break; if (sp > XB_SPIN_CAP) { atomicAdd(&bar[XB_TMO], 1u); break; } }
    }
    nloc = mine > 0u ? mine : 1u; nx = cnt > 0u ? cnt : 1u;
}
__device__ __forceinline__ void xcd_barrier(const XcdBarrier& b) {
    asm volatile("s_waitcnt vmcnt(0)" ::: "memory");
    __syncthreads();
    if (threadIdx.x == 0) {
        unsigned* bar = b.bar;
        __builtin_amdgcn_s_waitcnt(0);
        unsigned nloc = b.st[0], nx = b.st[1];
        if (nloc == 0u) { xcd_barrier_complete(bar, b.x, nloc, nx); b.st[0] = nloc; b.st[1] = nx; }
        const unsigned old = xb_add(&bar[XB_XSUB(b.x)], 1u);
        const unsigned gen = old / nloc;
        if (old + 1u == (gen + 1u) * nloc) {
            __builtin_amdgcn_fence(__ATOMIC_RELEASE, "agent");
            asm volatile("s_waitcnt vmcnt(0)" ::: "memory");
            const unsigned og = xb_add(&bar[XB_TOP], 1u);
            const unsigned tg = og / nx;
            if (og + 1u == (tg + 1u) * nx) xb_add(&bar[XB_TOPGEN], 1u);
            else XB_SPIN(xb_ld(&bar[XB_TOPGEN]) == tg, bar);
            __builtin_amdgcn_fence(__ATOMIC_ACQUIRE, "agent");
            xb_add(&bar[XB_XGEN(b.x)], 1u);
            asm volatile("s_waitcnt vmcnt(0)" ::: "memory");
        } else {
            XB_SPIN(xb_ld(&bar[XB_XGEN(b.x)]) == gen, bar);
            __builtin_amdgcn_fence(__ATOMIC_ACQUIRE, "agent");
            asm volatile("s_waitcnt vmcnt(0)" ::: "memory");
        }
    }
    __syncthreads();
}

constexpr int LDS_BARST = LDS_BYTES - 64;
__device__ __forceinline__ void phase_inproj(LAS unsigned char* lds, int G, int bx) {
    const KP p = kparams();
    gm::StaticSched S; S.init(HROWS / 256, LDP / 256, G, bx); gm::EpiProj E{(bf16_t*)(p->ws + WS_PROJ)};
    gm::gemm_phase<gm::EpiProj, gm::StaticSched, false, false>(lds, (const bf16_t*)(p->ws + WS_H), (const bf16_t*)(p->ws + WS_WIN), 0, nullptr, S, E);
    constexpr int NUN = (HROWS / 256) * (LDP / 256);
    if (NUN % G != 0 && bx >= NUN % G) { __syncthreads(); convert_batches(lds, 1, 8u); }
}
__device__ __forceinline__ void phase_outproj(LAS unsigned char* lds, int G, int bx) {
    const KP p = kparams();
    gm::StaticSched S; S.init(NTOK / 256, D / 256, G, bx); gm::EpiOut E{(const bf16_t*)(p->ws + WS_H), (bf16_t*)(p->ws + WS_V1)};
    gm::gemm_phase<gm::EpiOut, gm::StaticSched, false, false>(lds, (const bf16_t*)(p->ws + WS_MIX), (const bf16_t*)(p->ws + WS_WOUT), 0, nullptr, S, E);
}
__global__ void __launch_bounds__(NTHREADS, 2) mk_fwd(Params p_args) {
    (void)p_args;
    extern __shared__ __attribute__((aligned(16))) unsigned char lds_raw[];
    LAS unsigned char* lds = (LAS unsigned char*)lds_raw;
    const int G = gridDim.x, bx = blockIdx.x;
    const int vcu = (G % 8 == 0) ? (bx % 8) * (G / 8) + bx / 8 : bx;
    volatile LAS unsigned* barst = (volatile LAS unsigned*)(lds + LDS_BARST);
    if (threadIdx.x < 16) barst[threadIdx.x] = 0u;
    __syncthreads();
    const XcdBarrier bar = xcd_barrier_post((unsigned*)(kparams()->ws + WS_CTL) + CW_BAR, barst);

#ifndef PROBE_DUP
#define PROBE_DUP -1
#endif
    for (int rep = 0; rep < (PROBE_DUP == 0 ? 2 : 1); ++rep) { phase_prep(lds, vcu, G); xcd_barrier(bar); }
    for (int rep = 0; rep < (PROBE_DUP == 1 ? 2 : 1); ++rep) { phase_inproj(lds, G, bx); xcd_barrier(bar); }
    for (int rep = 0; rep < (PROBE_DUP == 8 ? 2 : 1); ++rep) { phase_pre(lds, vcu, G); xcd_barrier(bar); }
    for (int rep = 0; rep < (PROBE_DUP == 2 ? 2 : 1); ++rep) { phase_mixer(lds, bx, G); xcd_barrier(bar); }
    for (int rep = 0; rep < (PROBE_DUP == 3 ? 2 : 1); ++rep) { phase_outproj(lds, G, bx); xcd_barrier(bar); }
    phase_ln1_router(lds, vcu, G);
    xcd_barrier(bar);
    for (int rep = 0; rep < (PROBE_DUP == 5 ? 2 : 1); ++rep) { phase_moe_gemm(lds, G, bx, 0, false); xcd_barrier(bar); }
    for (int rep = 0; rep < (PROBE_DUP == 6 ? 2 : 1); ++rep) { phase_moe_gemm(lds, G, bx, 0, true); xcd_barrier(bar); }
    for (int rep = 0; rep < (PROBE_DUP == 7 ? 2 : 1); ++rep) { phase_combine(lds, vcu, G); if (PROBE_DUP == 7) xcd_barrier(bar); }
}

extern "C" void kernel_launch(void* const* d_in, const int* in_sizes, int n_in, void* d_out, int out_size, void* d_ws, size_t ws_size, hipStream_t stream) {
    (void)in_sizes; (void)out_size;
    static int grid = 0;
    if (grid == 0) {
        if (n_in != 27 || ws_size < 1024 * MiB) { fprintf(stderr, "kernel_launch: unexpected n_in %d or ws_size %zu\n", n_in, ws_size); grid = -1; return; }
        int dev = 0, cus = 0, per_cu = 0;
        if (hipGetDevice(&dev) != hipSuccess || hipDeviceGetAttribute(&cus, hipDeviceAttributeMultiprocessorCount, dev) != hipSuccess) { grid = -1; return; }
        if (hipFuncSetAttribute((const void*)mk_fwd, hipFuncAttributeMaxDynamicSharedMemorySize, LDS_BYTES) != hipSuccess) { fprintf(stderr, "kernel_launch: hipFuncSetAttribute failed\n"); grid = -1; return; }
        if (hipOccupancyMaxActiveBlocksPerMultiprocessor(&per_cu, (const void*)mk_fwd, NTHREADS, LDS_BYTES) != hipSuccess || per_cu < 1) { fprintf(stderr, "kernel_launch: occupancy query says %d blocks per CU\n", per_cu); per_cu = 1; }
        (void)hipGetLastError();
        grid = cus;
        if (grid > 256) grid = 256;
    }
    if (grid < 0) return;
    Params p{};
    for (int i = 0; i < 27; ++i) p.in[i] = (const float*)d_in[i];
    p.out = (float*)d_out; p.ws = (unsigned char*)d_ws; p.pass = 0; p.pad = 0;
    (void)hipMemsetAsync((char*)d_ws + WS_CTL, 0, CTL_BYTES, stream);
    hipLaunchKernelGGL(mk_fwd, dim3(grid), dim3(NTHREADS), LDS_BYTES, stream, p);
}
```

```cpp
#include <hip/hip_runtime.h>
#include <cstdio>
#include <cstdint>

#define LAS __attribute__((address_space(3)))
typedef unsigned short bf16_t;
typedef short bf16x8 __attribute__((ext_vector_type(8)));
typedef float f32x4 __attribute__((ext_vector_type(4)));
typedef float f32x16 __attribute__((ext_vector_type(16)));
typedef unsigned u32x4 __attribute__((ext_vector_type(4)));
typedef unsigned u32x2 __attribute__((ext_vector_type(2)));

constexpr int D = 1024, NB = 32, SEQ = 2048, NTOK = NB * SEQ, NMETA = 16;
constexpr int NCH = 33, LP = 2112;
constexpr int NPROJ = 3096, LDP = 3328;
constexpr int C_XBC = 0, C_Q = 1024, C_K = 1280, C_V = 1536, C_OG = 2048, C_Z = 2560, C_A1 = 3072, C_DT = 3088;
__host__ __device__ constexpr int proj_col(int n) { return n < 256 ? C_Q + n : n < 512 ? C_K + (n - 256) : n < 1024 ? C_V + (n - 512) : n < 1536 ? C_OG + (n - 1024) : n < 1552 ? C_A1 + (n - 1536) : n < 2064 ? C_Z + (n - 1552) : n < 3088 ? C_XBC + (n - 2064) : C_DT + (n - 3088); }
constexpr int NE = 32;
constexpr float ALPHA = 1.18920711500272f;
constexpr float LN_EPS = 1e-5f, RMS_EPS = 1e-6f;
constexpr int HROWS = NTOK + 256;
constexpr int NTHREADS = 512, NWAVES = 8;

constexpr size_t MiB = 1u << 20;
constexpr size_t WS_CTL = 0, CTL_BYTES = 1 * MiB;
constexpr size_t WS_RWT = 512 * 1024;
constexpr size_t WS_WIN = 1 * MiB, WS_WOUT = 8 * MiB, WS_TLIST = 138 * MiB, WS_TOKSLOT = 146 * MiB, WS_TOKGATE = 147 * MiB;
constexpr size_t WS_Y = 148 * MiB, WS_HID = 676 * MiB, WS_H1Q = 940 * MiB;
constexpr size_t WS_H = 148 * MiB, WS_PROJ = 277 * MiB, WS_MIX = 706 * MiB, WS_V1 = 10 * MiB;
constexpr int HID_CAP_BLOCKS = NTOK * 4 / 256 + NE;
constexpr int W8_PITCH = D + 128;
constexpr size_t OUT_WGU = 0, OUT_WD = 80 * MiB;
static_assert((size_t)NE * 2048 * W8_PITCH <= OUT_WD && OUT_WD + (size_t)NE * D * W8_PITCH <= 256 * MiB, "expert weight copies fit in d_out");
constexpr float WD6_SCALE = 128.0f;
constexpr float H6_SCALE = 2.0f;
constexpr float W8_SCALE = 64.0f, HID8_SCALE = 8.0f, Y8_SCALE = 32.0f;
static_assert(WS_H + (size_t)HROWS * D * 2 <= WS_PROJ && WS_PROJ + (size_t)NB * LP * LDP * 2 <= WS_MIX && WS_MIX + (size_t)NTOK * D * 2 <= WS_H1Q, "ws map");
static_assert(WS_HID + (size_t)HID_CAP_BLOCKS * 256 * D <= WS_H1Q && WS_H1Q + (size_t)NTOK * D <= 1024 * MiB && WS_Y + (size_t)(NTOK * 4 + NE * 256) * D * 2 <= WS_HID, "ws map 2");
constexpr int LDS_BYTES = 163840;

__device__ __forceinline__ float bf2f(unsigned b) { return __uint_as_float(b << 16); }
typedef __bf16 bf16x2_t __attribute__((ext_vector_type(2)));
typedef float f32x2_t __attribute__((ext_vector_type(2)));
typedef short s16x4 __attribute__((ext_vector_type(4)));
typedef __bf16 bf16x32_t __attribute__((ext_vector_type(32)));
typedef unsigned u32x16 __attribute__((ext_vector_type(16)));
typedef unsigned u32x6 __attribute__((ext_vector_type(6)));
__device__ __forceinline__ u32x6 cvt_fp6x32(u32x16 v) { return __builtin_bit_cast(u32x6, __builtin_amdgcn_cvt_scalef32_pk32_fp6_bf16(__builtin_bit_cast(bf16x32_t, v), 1.0f)); }
__device__ __forceinline__ void store_fp6_block(unsigned char* slot, int g, u32x6 r) {
    *(u32x4*)(slot + 16 * g) = (u32x4){r[0], r[1], r[2], r[3]}; *(u32x2*)(slot + 64 + 8 * g) = (u32x2){r[4], r[5]}; }
__device__ __forceinline__ unsigned cvt_pk_bf16(float lo, float hi) { const f32x2_t f = {lo, hi}; return __builtin_bit_cast(unsigned, __builtin_convertvector(f, bf16x2_t)); }
__device__ __forceinline__ float clamp448(float x) { return fminf(fmaxf(x, -448.f), 448.f); }
__device__ __forceinline__ unsigned cvt_fp8x4_nc(float a, float b, float c, float d) {
    unsigned w = 0; w = __builtin_amdgcn_cvt_pk_fp8_f32(a, b, w, false); w = __builtin_amdgcn_cvt_pk_fp8_f32(c, d, w, true); return w; }
__device__ __forceinline__ unsigned cvt_fp8x4(float a, float b, float c, float d) {
    unsigned w = 0; w = __builtin_amdgcn_cvt_pk_fp8_f32(clamp448(a), clamp448(b), w, false); w = __builtin_amdgcn_cvt_pk_fp8_f32(clamp448(c), clamp448(d), w, true); return w; }
__device__ __forceinline__ bf16_t f2bf(float f) { return (bf16_t)(cvt_pk_bf16(f, 0.f) & 0xffffu); }
__device__ __forceinline__ float wave_sum(float v) {
    v += __builtin_bit_cast(float, __builtin_amdgcn_mov_dpp(__builtin_bit_cast(int, v), 0xB1, 0xf, 0xf, true));
    v += __builtin_bit_cast(float, __builtin_amdgcn_mov_dpp(__builtin_bit_cast(int, v), 0x4E, 0xf, 0xf, true));
    v += __builtin_bit_cast(float, __builtin_amdgcn_mov_dpp(__builtin_bit_cast(int, v), 0x141, 0xf, 0xf, true));
    v += __builtin_bit_cast(float, __builtin_amdgcn_mov_dpp(__builtin_bit_cast(int, v), 0x140, 0xf, 0xf, true));
    v += __shfl_xor(v, 16); v += __shfl_xor(v, 32);
    return v;
}
template <int CTRL> __device__ __forceinline__ float dppx_f(float v) { return __builtin_bit_cast(float, __builtin_amdgcn_mov_dpp(__builtin_bit_cast(int, v), CTRL, 0xf, 0xf, true)); }
template <int CTRL> __device__ __forceinline__ int dppx_i(int v) { return __builtin_amdgcn_mov_dpp(v, CTRL, 0xf, 0xf, true); }
__device__ __forceinline__ float wave_scan_incl(float v) {
    v += __builtin_bit_cast(float, __builtin_amdgcn_update_dpp(0, __builtin_bit_cast(int, v), 0x111, 0xf, 0xf, true));
    v += __builtin_bit_cast(float, __builtin_amdgcn_update_dpp(0, __builtin_bit_cast(int, v), 0x112, 0xf, 0xf, true));
    v += __builtin_bit_cast(float, __builtin_amdgcn_update_dpp(0, __builtin_bit_cast(int, v), 0x114, 0xf, 0xf, true));
    v += __builtin_bit_cast(float, __builtin_amdgcn_update_dpp(0, __builtin_bit_cast(int, v), 0x118, 0xf, 0xf, true));
    v += __builtin_bit_cast(float, __builtin_amdgcn_update_dpp(0, __builtin_bit_cast(int, v), 0x142, 0xa, 0xf, false));
    v += __builtin_bit_cast(float, __builtin_amdgcn_update_dpp(0, __builtin_bit_cast(int, v), 0x143, 0xc, 0xf, false));
    return v;
}
__device__ __forceinline__ float fast_rcp(float x) { return __builtin_amdgcn_rcpf(x); }
__device__ __forceinline__ float fast_exp(float x) { return __builtin_amdgcn_exp2f(x * 1.4426950408889634f); }
__device__ __forceinline__ float fast_log(float x) { return __builtin_amdgcn_logf(x) * 0.6931471805599453f; }
__device__ __forceinline__ float fast_rsq(float x) { return __builtin_amdgcn_rsqf(x); }
__device__ __forceinline__ float silu_f(float x) { return x * fast_rcp(1.f + fast_exp(-x)); }
__device__ __forceinline__ f32x2_t silu_f2(f32x2_t x) {
    const f32x2_t t = x * (f32x2_t){-1.4426950408889634f, -1.4426950408889634f};
    f32x2_t e = {__builtin_amdgcn_exp2f(t.x), __builtin_amdgcn_exp2f(t.y)};
    e = e + (f32x2_t){1.f, 1.f};
    return x * (f32x2_t){fast_rcp(e.x), fast_rcp(e.y)};
}
__device__ __forceinline__ f32x2_t bf2f2(unsigned w) { return (f32x2_t){__builtin_bit_cast(float, w << 16), __builtin_bit_cast(float, w & 0xffff0000u)}; }
#define LDS_WAIT() asm volatile("s_waitcnt lgkmcnt(0)" ::: "memory")
__device__ __forceinline__ int opaque_tid() { int t = threadIdx.x; asm volatile("" : "+v"(t)); return t & (NTHREADS - 1); }

struct Params { const float* in[27]; float* out; unsigned char* ws; int pass; int pad; };
typedef const __attribute__((address_space(4))) Params* KP;
__device__ __forceinline__ KP kparams() { KP q = (KP)__builtin_amdgcn_kernarg_segment_ptr(); asm volatile("" : "+s"(q)); return q; }

namespace gm {
constexpr int BM = 256, BK = 64, HALF = 128, HTB = HALF * BK * 2, STAGE_BYTES = 8 * HTB, NXCD = 8, WGM = 8;
constexpr int K = 1024;
constexpr size_t KSTEP = BK * 2;

__device__ __forceinline__ int lds_byte(int r, int c) { return (r >> 3) * 1024 + (r & 7) * 128 + 16 * ((c >> 3) ^ ((r >> 1) & 7)); }
__device__ __forceinline__ void stage_rc(int b, int& R, int& C) { R = 8 * (b >> 10) + ((b >> 7) & 7); C = 8 * (((b >> 4) & 7) ^ ((R >> 1) & 7)); }
__device__ __forceinline__ int perm32(int rho) { const int n = rho >> 4, i = rho & 15; return 8 * (i >> 2) + 4 * n + (i & 3); }

struct Unit { int arow, nvalid, pn, bsel, orow; };

struct StaticSched {
    int nM, nN, nwg, G, c;
    __device__ void init(int nM_, int nN_, int G_, int c_) { nM = nM_; nN = nN_; nwg = nM * nN; G = G_; c = c_; }
    __device__ bool next(int i, Unit& u) const {
        const long L = (long)i * G + c; if (L >= nwg) return false;
        int wgid = (int)L; { const int q = nwg / NXCD, r = nwg % NXCD, xcd = wgid % NXCD, off = wgid / NXCD; wgid = (xcd < r ? xcd * (q + 1) : r * (q + 1) + (xcd - r) * q) + off; }
        const int nig = WGM * nN, gid = wgid / nig, fm = gid * WGM, gsz = (nM - fm) < WGM ? (nM - fm) : WGM;
        const int pm = fm + ((wgid % nig) % gsz), pn = (wgid % nig) / gsz;
        u.arow = pm * BM; u.nvalid = BM; u.pn = pn; u.bsel = 0; u.orow = pm * BM; return true;
    }
};

struct MoeSched {
    const int* cnt; int e0, e1, npn, G, c, ybase0; bool second;
    mutable int pe, pbase, phrow;
    __device__ void reset() { pe = e0; pbase = 0; phrow = 0; }
    __device__ bool next(int i, Unit& u) const {
        const long L = (long)i * G + c;
        while (pe < e1) {
            const int n = cnt[pe], nrb = (n + 255) >> 8, ntile = nrb * npn;
            if (L < (long)pbase + ntile) {
                const int l = (int)(L - pbase), nig = WGM * npn, grp = l / nig, within = l % nig, fm = grp * WGM, gsz = (nrb - fm) < WGM ? (nrb - fm) : WGM;
                const int rb = fm + within % gsz, pn = within / gsz;
                u.pn = pn; u.bsel = pe;
                if (!second) { u.arow = pe * NTOK + rb * 256; u.nvalid = n - rb * 256; u.orow = phrow + rb * 256; }
                else { u.arow = phrow + rb * 256; u.nvalid = BM; u.orow = ybase0 + phrow + rb * 256; }
                return true;
            }
            pbase += ntile; phrow += nrb * 256; ++pe;
        }
        return false;
    }
};

typedef int v8i __attribute__((ext_vector_type(8)));
__device__ __forceinline__ bf16x8 ld_half8(const LAS unsigned char* p) { const s16x4 lo = *(const LAS s16x4*)p; return __builtin_bit_cast(bf16x8, __builtin_shufflevector(lo, lo, 0, 1, 2, 3, -1, -1, -1, -1)); }
template <bool F8, bool F6, bool F6B> __device__ __forceinline__ f32x4 mma_step(const bf16x8 (&b)[2], const bf16x8 (&a)[2], f32x4 c) {
    if constexpr (F8) {
        const v8i bb = __builtin_bit_cast(v8i, __builtin_shufflevector(b[0], b[1], 0, 1, 2, 3, 4, 5, 6, 7, 8, 9, 10, 11, 12, 13, 14, 15));
        const v8i aa = __builtin_bit_cast(v8i, __builtin_shufflevector(a[0], a[1], 0, 1, 2, 3, 4, 5, 6, 7, 8, 9, 10, 11, 12, 13, 14, 15));
        if constexpr (F6) return __builtin_amdgcn_mfma_scale_f32_16x16x128_f8f6f4(bb, aa, c, 2, 2, 0, 0x7f7f7f7f, 0, 0x7f7f7f7f);
        else if constexpr (F6B) return __builtin_amdgcn_mfma_scale_f32_16x16x128_f8f6f4(bb, aa, c, 2, 0, 0, 0x7f7f7f7f, 0, 0x7f7f7f7f);
        else return __builtin_amdgcn_mfma_scale_f32_16x16x128_f8f6f4(bb, aa, c, 0, 0, 0, 0x7f7f7f7f, 0, 0x7f7f7f7f);
    } else {
        c = __builtin_amdgcn_mfma_f32_16x16x32_bf16(b[0], a[0], c, 0, 0, 0);
        return __builtin_amdgcn_mfma_f32_16x16x32_bf16(b[1], a[1], c, 0, 0, 0);
    }
}
template <class Epi, class Sched, bool GATHER, bool F8, bool F6 = false, bool F6B = false>
__device__ __forceinline__ void gemm_phase(LAS unsigned char* lds, const bf16_t* Abase, const bf16_t* Btbase, size_t bsel_bytes, const int* glist, const Sched& S, const Epi& E) {
    const int tid = opaque_tid(), wid = __builtin_amdgcn_readfirstlane(tid >> 6), lane = tid & 63, wr = wid >> 2, wc = wid & 3, fr = lane & 15, fq = lane >> 4;
    constexpr int RB = F8 ? K : 2 * K, NT = RB / 128;
    constexpr int RBB = F8 ? W8_PITCH : RB;
    constexpr size_t HSTEP = (size_t)HALF * RB, TSTEP = (size_t)BM * RBB, BHALF = (size_t)32 * RBB;
    unsigned voffB[2]; unsigned long long dmask = ~0ull;
    { int R0, C0, R1, C1; stage_rc(tid * 16, R0, C0); stage_rc(tid * 16 + 8192, R1, C1);
      if (F6 || F6B) dmask = __builtin_amdgcn_ballot_w64(C0 < 48);
      const int Rb0 = 64 * (R0 >> 5) + perm32(R0 & 31), Rb1 = 64 * (R1 >> 5) + perm32(R1 & 31);
      voffB[0] = (unsigned)(Rb0 * RBB + C0 * 2); voffB[1] = (unsigned)(Rb1 * RBB + C1 * 2); }
    const unsigned ldsw = (unsigned)wid * 1024u;
    const int pa = F6 ? fq : (F6B ? fq : (F8 ? (fq & 1) + 4 * (fq >> 1) : fq)), pb = F6 ? 4 + (fq >> 1) : (F6B ? 4 + fq : (F8 ? pa + 2 : 4 + fq)), ph = F6 ? 8 * (fq & 1) : 0;
    const int pa6 = (F6 || F6B) ? fq : pa, pb6 = (F6 || F6B) ? 4 + (fq >> 1) : pb, ph6 = (F6 || F6B) ? 8 * (fq & 1) : 0;
    const int aoff = lds_byte(wr * 64 + fr, 8 * pa), aoff2 = lds_byte(wr * 64 + fr, 8 * pb) + ph, boff = lds_byte(wc * 32 + fr, 8 * pa6), boff2 = lds_byte(wc * 32 + fr, 8 * pb6) + ph6;
#define G_SA(b, h) (((b) * 2 + (h)) * HTB)
#define G_SB(b, h) ((4 + (b) * 2 + (h)) * HTB)
#define G_STAGE2M(MASKED, bufoff, gbase, o0, o1) do { \
        if (MASKED) { unsigned m0s_; asm volatile("s_mov_b32 %0, m0\n\ts_mov_b32 m0, %1\n\ts_mov_b64 exec, %3\n\tglobal_load_lds_dwordx4 %4, %6\n\ts_mov_b32 m0, %2\n\ts_nop 0\n\tglobal_load_lds_dwordx4 %5, %6\n\ts_mov_b64 exec, -1\n\ts_mov_b32 m0, %0" \
                : "=&s"(m0s_) : "s"((unsigned)(size_t)(lds + (bufoff) + ldsw)), "s"((unsigned)(size_t)(lds + (bufoff) + ldsw + 8192)), "s"(dmask), "v"((unsigned)(o0)), "v"((unsigned)(o1)), "s"((const char*)(gbase)) : "memory"); } \
        else { \
        __builtin_amdgcn_global_load_lds((const unsigned*)((const char*)(gbase) + (o0)), (LAS unsigned*)(lds + (bufoff) + ldsw), 16, 0, 0); \
        __builtin_amdgcn_global_load_lds((const unsigned*)((const char*)(gbase) + (o1)), (LAS unsigned*)(lds + (bufoff) + ldsw + 8192), 16, 0, 0); } } while (0)
#define G_STAGE2(bufoff, gbase, o0, o1) G_STAGE2M(F6, bufoff, gbase, o0, o1)
#define G_STAGE2B(bufoff, gbase, o0, o1) G_STAGE2M(F6 || F6B, bufoff, gbase, o0, o1)
#define G_LD2(ptr) (F6 ? ld_half8(ptr) : *(const LAS bf16x8*)(ptr))
#define G_LD2B(ptr) ((F6 || F6B) ? ld_half8(ptr) : *(const LAS bf16x8*)(ptr))
#define G_LDA(dst, b, h) do { _Pragma("unroll") for (int m = 0; m < 4; ++m) { dst[m][0] = *(const LAS bf16x8*)(lds + G_SA(b, h) + aoff + m * 2048); dst[m][1] = G_LD2(lds + G_SA(b, h) + aoff2 + m * 2048); } } while (0)
#define G_LDB(dst, b, h) do { _Pragma("unroll") for (int n = 0; n < 2; ++n) { dst[n][0] = *(const LAS bf16x8*)(lds + G_SB(b, h) + boff + n * 2048); dst[n][1] = G_LD2B(lds + G_SB(b, h) + boff2 + n * 2048); } } while (0)
#define G_MMA(ai, bj, At, Bt) do { __builtin_amdgcn_s_setprio(1); _Pragma("unroll") for (int m = 0; m < 4; ++m) _Pragma("unroll") for (int n = 0; n < 2; ++n) \
        acc[ai][bj][m][n] = mma_step<F8, F6, F6B>(Bt[n], At[m], acc[ai][bj][m][n]); __builtin_amdgcn_s_setprio(0); } while (0)
#define G_WAIT_V(n) asm volatile("s_waitcnt vmcnt(" #n ")" ::: "memory")
#define G_WAIT_L(n) asm volatile("s_waitcnt lgkmcnt(" #n ")" ::: "memory")
#define G_BAR __builtin_amdgcn_s_barrier()
#define G_SCHED __builtin_amdgcn_sched_barrier(0)
#define G_TOK(tk, u) do { int R0, C0, R1, C1; { const int t2 = opaque_tid(); stage_rc(t2 * 16, R0, C0); stage_rc(t2 * 16 + 8192, R1, C1); } if (GATHER) { \
            tk[0] = R0 < (u).nvalid ? glist[(u).arow + R0] : 0; tk[1] = R1 < (u).nvalid ? glist[(u).arow + R1] : 0; \
            tk[2] = 128 + R0 < (u).nvalid ? glist[(u).arow + 128 + R0] : 0; tk[3] = 128 + R1 < (u).nvalid ? glist[(u).arow + 128 + R1] : 0; } \
        else { tk[0] = (u).arow + R0; tk[1] = (u).arow + R1; tk[2] = (u).arow + 128 + R0; tk[3] = (u).arow + 128 + R1; } } while (0)
#define G_AOFF(dst, tk) do { int R0, C0, R1, C1; { const int t2 = opaque_tid(); stage_rc(t2 * 16, R0, C0); stage_rc(t2 * 16 + 8192, R1, C1); } dst[0][0] = (unsigned)(tk[0] * RB + C0 * 2); dst[0][1] = (unsigned)(tk[1] * RB + C1 * 2); dst[1][0] = (unsigned)(tk[2] * RB + C0 * 2); dst[1][1] = (unsigned)(tk[3] * RB + C1 * 2); } while (0)
    Unit cur, nxt; int ui = 0;
    if (!S.next(0, cur)) return;
    f32x4 acc[2][2][4][2];
#pragma unroll
    for (int a = 0; a < 2; ++a)
#pragma unroll
        for (int b = 0; b < 2; ++b)
#pragma unroll
            for (int m = 0; m < 4; ++m)
#pragma unroll
                for (int n = 0; n < 2; ++n) acc[a][b][m][n] = (f32x4){0.f, 0.f, 0.f, 0.f};
    bf16x8 At[4][2], B0[2][2], B1[2][2];
    unsigned ao[2][2]; int tk[4];
    G_TOK(tk, cur); G_AOFF(ao, tk);
    LAS unsigned char* const lbias = lds + STAGE_BYTES + 1024;
    if (Epi::HAS_BIAS && wid == 1) __builtin_amdgcn_global_load_lds((const unsigned*)E.bias_ptr(cur, lane), (LAS unsigned*)lbias, 16, 0, 0);
    const char* const cA = (const char*)Abase;
    const char* cB = (const char*)Btbase + (size_t)cur.bsel * bsel_bytes + (size_t)cur.pn * TSTEP;
    G_STAGE2B(G_SB(0, 0), cB, voffB[0], voffB[1]); G_STAGE2B(G_SB(0, 1), cB + BHALF, voffB[0], voffB[1]); G_STAGE2(G_SA(0, 0), cA, ao[0][0], ao[0][1]); G_STAGE2(G_SA(0, 1), cA, ao[1][0], ao[1][1]);
    if (wr == 1) G_BAR;
    G_WAIT_V(2); G_BAR;
    G_STAGE2B(G_SB(1, 0), cB + KSTEP, voffB[0], voffB[1]); G_STAGE2(G_SA(1, 0), cA + KSTEP, ao[0][0], ao[0][1]); G_STAGE2B(G_SB(1, 1), cB + BHALF + KSTEP, voffB[0], voffB[1]);
    G_WAIT_V(6); G_BAR;
    for (;;) {
        const bool has_next = S.next(ui + 1, nxt);
        const char* nB = has_next ? (const char*)Btbase + (size_t)nxt.bsel * bsel_bytes + (size_t)nxt.pn * TSTEP : cB;
#pragma unroll 1
        for (int t = 0; t < NT; t += 2) {
            const bool last = (t == NT - 2);
            if (Epi::HAS_BIAS && t == NT - 4 && has_next && wid == 1)
                __builtin_amdgcn_global_load_lds((const unsigned*)E.bias_ptr(nxt, lane), (LAS unsigned*)(lbias + 1024 * ((ui + 1) & 1)), 16, 0, 0);
            if (GATHER && t == NT - 4 && has_next && wid == 0)
                __builtin_amdgcn_global_load_lds((const unsigned*)(glist + nxt.arow + 4 * lane), (LAS unsigned*)(lds + STAGE_BYTES), 16, 0, 0);
            const char* a1 = cA + (size_t)(t + 1) * KSTEP;
            const char* a2 = last ? cA : cA + (size_t)(t + 2) * KSTEP; const char* b2 = last ? nB : cB + (size_t)(t + 2) * KSTEP;
            const char* a3 = a2 + KSTEP; const char* b3 = b2 + KSTEP;
            G_LDB(B0, 0, 0); G_LDB(B1, 0, 1); G_SCHED; G_LDA(At, 0, 0); G_STAGE2(G_SA(1, 1), a1, ao[1][0], ao[1][1]);
            if (last && has_next) {
                if (GATHER) { int R0, C0, R1, C1; { const int t2 = opaque_tid(); stage_rc(t2 * 16, R0, C0); stage_rc(t2 * 16 + 8192, R1, C1); }
                    const LAS int* tl = (const LAS int*)(lds + STAGE_BYTES);
                    tk[0] = R0 < nxt.nvalid ? tl[R0] : 0; tk[1] = R1 < nxt.nvalid ? tl[R1] : 0; tk[2] = 128 + R0 < nxt.nvalid ? tl[128 + R0] : 0; tk[3] = 128 + R1 < nxt.nvalid ? tl[128 + R1] : 0; }
                else G_TOK(tk, nxt);
                G_AOFF(ao, tk); }
            G_WAIT_V(8); G_WAIT_L(0); G_BAR; G_MMA(0, 0, At, B0); G_MMA(0, 1, At, B1); G_BAR; G_SCHED;
            G_LDA(At, 0, 1); G_STAGE2B(G_SB(0, 0), b2, voffB[0], voffB[1]); G_STAGE2B(G_SB(0, 1), b2 + BHALF, voffB[0], voffB[1]); G_STAGE2(G_SA(0, 0), a2, ao[0][0], ao[0][1]);
            G_WAIT_V(8); G_WAIT_L(0); G_BAR; G_MMA(1, 0, At, B0); G_MMA(1, 1, At, B1); G_BAR; G_SCHED;
            G_LDB(B0, 1, 0); G_LDB(B1, 1, 1); G_SCHED; G_LDA(At, 1, 0); G_STAGE2(G_SA(0, 1), a2, ao[1][0], ao[1][1]);
            G_WAIT_V(8); G_WAIT_L(0); G_BAR; G_MMA(0, 0, At, B0); G_MMA(0, 1, At, B1); G_BAR; G_SCHED;
            G_LDA(At, 1, 1); G_STAGE2B(G_SB(1, 0), b3, voffB[0], voffB[1]); G_STAGE2B(G_SB(1, 1), b3 + BHALF, voffB[0], voffB[1]); G_STAGE2(G_SA(1, 0), a3, ao[0][0], ao[0][1]);
            G_WAIT_V(8); G_WAIT_L(0); G_BAR; G_MMA(1, 0, At, B0); G_MMA(1, 1, At, B1); G_BAR; G_SCHED;
        }
        if (wr == 0) G_BAR;
        E(acc, cur, wr, wc, fr, fq, (const LAS float*)(lbias + 1024 * (ui & 1)));
        if (!has_next) break;
#pragma unroll
        for (int a = 0; a < 2; ++a)
#pragma unroll
            for (int b = 0; b < 2; ++b)
#pragma unroll
                for (int m = 0; m < 4; ++m)
#pragma unroll
                    for (int n = 0; n < 2; ++n) acc[a][b][m][n] = (f32x4){0.f, 0.f, 0.f, 0.f};
        cur = nxt; cB = nB; ++ui;
        if (wr == 1) G_BAR;
    }
    G_WAIT_V(0);
    G_BAR;
#undef G_SA
#undef G_SB
#undef G_STAGE2
#undef G_STAGE2B
#undef G_STAGE2M
#undef G_LD2B
#undef G_LD2
#undef G_LDA
#undef G_LDB
#undef G_MMA
#undef G_WAIT_V
#undef G_WAIT_L
#undef G_BAR
#undef G_SCHED
#undef G_AOFF
#undef G_TOK
}

__device__ __forceinline__ unsigned dpp_ror8(unsigned v) { return (unsigned)__builtin_amdgcn_mov_dpp((int)v, 0x128, 0xf, 0xf, true); }
__device__ __forceinline__ void store_lines(bf16_t* g16  , size_t pitch, int fr, const u32x4& w0, const u32x4& w1) {
    const bool lo = fr < 8;
    const u32x4 t = lo ? w1 : w0;
    u32x4 r; r.x = dpp_ror8(t.x); r.y = dpp_ror8(t.y); r.z = dpp_ror8(t.z); r.w = dpp_ror8(t.w);
    bf16_t* pa = g16 + (size_t)(fr & 7) * pitch + (lo ? 0 : 32);
    *(u32x4*)pa = lo ? w0 : r;
    *(u32x4*)(pa + 8 * pitch) = lo ? r : w1;
}
struct EpiProj {
    static constexpr bool PERM = true;
    static constexpr bool HAS_BIAS = false;
    bf16_t* P;
    __device__ __forceinline__ const float* bias_ptr(const Unit&, int) const { return nullptr; }
    __device__ __forceinline__ void operator()(const f32x4 (&acc)[2][2][4][2], const Unit& u, int wr, int wc, int fr, int fq, const LAS float*) const {
        const int col0 = u.pn * BM + wc * 64 + 8 * fq;
        const bool meta = (u.arow == NTOK);
        const int pm = u.arow >> 8;
        const int orow0 = u.arow + 64 * ((pm >> 3) + 1);
#pragma unroll
        for (int ai = 0; ai < 2; ++ai)
#pragma unroll
            for (int m = 0; m < 4; ++m) {
                const int lr0 = ai * HALF + wr * 64 + m * 16, lr = lr0 + fr;
                u32x4 w[2];
#pragma unroll
                for (int bj = 0; bj < 2; ++bj) { const f32x4 v0 = acc[ai][bj][m][0], v1 = acc[ai][bj][m][1];
                    w[bj].x = cvt_pk_bf16(v0[0], v0[1]); w[bj].y = cvt_pk_bf16(v0[2], v0[3]); w[bj].z = cvt_pk_bf16(v1[0], v1[1]); w[bj].w = cvt_pk_bf16(v1[2], v1[3]); }
                if (!meta) store_lines(P + (size_t)(orow0 + lr0) * LDP + col0, LDP, fr, w[0], w[1]);
                else if (lr < NMETA) { for (int b = 0; b < NB; ++b) { bf16_t* q = P + (size_t)(b * LP + 48 + lr) * LDP + col0; *(u32x4*)q = w[0]; *(u32x4*)(q + 32) = w[1]; } }
            }
    }
};
struct EpiOut {
    static constexpr bool PERM = true;
    static constexpr bool HAS_BIAS = false;
    const bf16_t* H; bf16_t* V;
    __device__ __forceinline__ const float* bias_ptr(const Unit&, int) const { return nullptr; }
    __device__ __forceinline__ void operator()(const f32x4 (&acc)[2][2][4][2], const Unit& u, int wr, int wc, int fr, int fq, const LAS float*) const {
        const int col0 = u.pn * BM + wc * 64 + 8 * fq;
#pragma unroll
        for (int ai = 0; ai < 2; ++ai)
#pragma unroll
            for (int m = 0; m < 4; ++m) {
                const size_t row0 = (size_t)(u.arow + ai * HALF + wr * 64 + m * 16), row = row0 + fr;
                u32x4 w[2];
#pragma unroll
                for (int bj = 0; bj < 2; ++bj) {
                    const u32x4 h = *(const u32x4*)(H + row * D + col0 + bj * 32);
                    const f32x4 v0 = acc[ai][bj][m][0], v1 = acc[ai][bj][m][1];
                    w[bj].x = cvt_pk_bf16(v0[0] + ALPHA * bf2f(h.x & 0xffffu), v0[1] + ALPHA * bf2f(h.x >> 16));
                    w[bj].y = cvt_pk_bf16(v0[2] + ALPHA * bf2f(h.y & 0xffffu), v0[3] + ALPHA * bf2f(h.y >> 16));
                    w[bj].z = cvt_pk_bf16(v1[0] + ALPHA * bf2f(h.z & 0xffffu), v1[1] + ALPHA * bf2f(h.z >> 16));
                    w[bj].w = cvt_pk_bf16(v1[2] + ALPHA * bf2f(h.w & 0xffffu), v1[3] + ALPHA * bf2f(h.w >> 16));
                }
                store_lines(V + row0 * D + col0, D, fr, w[0], w[1]);
            }
    }
};
__device__ __forceinline__ float swiglu(float a, float u) {
    a = fminf(a, 7.0f); u = fminf(fmaxf(u, -7.0f), 7.0f);
    return a * fast_rcp(1.f + fast_exp(-1.702f * a)) * (u + 1.0f);
}
__device__ __forceinline__ float swiglu8(float a, float u) {
    a = fminf(a, 7.0f); u = fminf(fmaxf(u, -7.0f), 7.0f);
    const float sg = fast_rcp(1.f + __builtin_amdgcn_exp2f(a * (-1.702f * 1.4426950408889634f)));
    return fminf((a * sg) * (u * HID8_SCALE + HID8_SCALE), 448.f);
}
__device__ __forceinline__ f32x2_t swiglu8x2(f32x2_t a, f32x2_t u) {
    a.x = fminf(a.x, 7.0f); a.y = fminf(a.y, 7.0f); u.x = fminf(fmaxf(u.x, -7.0f), 7.0f); u.y = fminf(fmaxf(u.y, -7.0f), 7.0f);
    const f32x2_t t = a * (f32x2_t){-1.702f * 1.4426950408889634f, -1.702f * 1.4426950408889634f};
    f32x2_t e = {__builtin_amdgcn_exp2f(t.x), __builtin_amdgcn_exp2f(t.y)};
    e = e + (f32x2_t){1.f, 1.f};
    const f32x2_t sg = {fast_rcp(e.x), fast_rcp(e.y)};
    return (a * sg) * (u * (f32x2_t){HID8_SCALE, HID8_SCALE} + (f32x2_t){HID8_SCALE, HID8_SCALE});
}
struct EpiSwiglu {
    static constexpr bool PERM = true;
    static constexpr bool HAS_BIAS = true;
    unsigned char* HID; const float* bg; const float* bu;
    __device__ __forceinline__ const float* bias_ptr(const Unit& u, int lane) const { return (lane < 32 ? bg : bu) + (size_t)u.bsel * D + u.pn * HALF + 4 * (lane & 31); }
    __device__ __forceinline__ void operator()(const f32x4 (&acc)[2][2][4][2], const Unit& u, int wr, int wc, int fr, int fq, const LAS float* lb) const {
        const int hc = u.pn * HALF + wc * 32 + 8 * fq, hl_ = wc * 32 + 8 * fq;
        const f32x4 g0 = *(const LAS f32x4*)(lb + hl_), g1 = *(const LAS f32x4*)(lb + hl_ + 4), u0 = *(const LAS f32x4*)(lb + 128 + hl_), u1 = *(const LAS f32x4*)(lb + 128 + hl_ + 4);
        constexpr float IS = 1.0f / (W8_SCALE * H6_SCALE);
#pragma unroll
        for (int ai = 0; ai < 2; ++ai)
#pragma unroll
            for (int m = 0; m < 4; ++m) {
                const size_t row = (size_t)(u.orow + ai * HALF + wr * 64 + m * 16 + fr);
                const f32x4 a0 = acc[ai][0][m][0] * IS + g0, a1 = acc[ai][0][m][1] * IS + g1, b0 = acc[ai][1][m][0] * IS + u0, b1 = acc[ai][1][m][1] * IS + u1;
                u32x2 w;
                const f32x2_t s0 = swiglu8x2((f32x2_t){a0[0], a0[1]}, (f32x2_t){b0[0], b0[1]}), s1 = swiglu8x2((f32x2_t){a0[2], a0[3]}, (f32x2_t){b0[2], b0[3]});
                const f32x2_t s2 = swiglu8x2((f32x2_t){a1[0], a1[1]}, (f32x2_t){b1[0], b1[1]}), s3 = swiglu8x2((f32x2_t){a1[2], a1[3]}, (f32x2_t){b1[2], b1[3]});
                w.x = cvt_fp8x4_nc(s0.x, s0.y, s1.x, s1.y);
                w.y = cvt_fp8x4_nc(s2.x, s2.y, s3.x, s3.y);
                *(u32x2*)(HID + row * D + hc) = w;
            }
    }
};
struct EpiDown {
    static constexpr bool PERM = true;
    static constexpr bool HAS_BIAS = true;
    unsigned char* Y; const float* bd;
    __device__ __forceinline__ const float* bias_ptr(const Unit& u, int lane) const { return bd + (size_t)u.bsel * D + u.pn * BM + 4 * lane; }
    __device__ __forceinline__ void operator()(const f32x4 (&acc)[2][2][4][2], const Unit& u, int wr, int wc, int fr, int fq, const LAS float* lb) const {
        const int col0 = u.pn * BM + wc * 64 + 8 * fq;
        const LAS float* pb = lb + wc * 64 + 8 * fq;
        f32x4 bv[2][2];
#pragma unroll
        for (int bj = 0; bj < 2; ++bj) { bv[bj][0] = *(const LAS f32x4*)(pb + bj * 32) * Y8_SCALE; bv[bj][1] = *(const LAS f32x4*)(pb + bj * 32 + 4) * Y8_SCALE; }
        constexpr float IS = Y8_SCALE / (WD6_SCALE * HID8_SCALE);
#pragma unroll
        for (int ai = 0; ai < 2; ++ai)
#pragma unroll
            for (int m = 0; m < 4; ++m) {
                unsigned char* rowp = Y + (size_t)(u.orow + ai * HALF + wr * 64 + m * 16 + fr) * D + col0;
#pragma unroll
                for (int bj = 0; bj < 2; ++bj) {
                    const f32x4 v0 = acc[ai][bj][m][0] * IS + bv[bj][0], v1 = acc[ai][bj][m][1] * IS + bv[bj][1];
                    u32x2 w; w.x = cvt_fp8x4(v0[0], v0[1], v0[2], v0[3]); w.y = cvt_fp8x4(v1[0], v1[1], v1[2], v1[3]);
                    *(u32x2*)(rowp + bj * 32) = w;
                }
            }
    }
};
}

__device__ __forceinline__ void transpose_item(const float* W, int N, int k0, int n0, bf16_t* WT, int drow0, LAS float* scr, int lane) {
    const int nn = n0 + (lane & 31); const bool ok = nn < N;
#pragma unroll 8
    for (int i = 0; i < 32; ++i) { const int kk = 2 * i + (lane >> 5); scr[kk * 33 + (lane & 31)] = ok ? W[(size_t)(k0 + kk) * N + nn] : 0.f; }
    LDS_WAIT(); asm volatile("" ::: "memory");
    const int c = lane & 7;
#pragma unroll
    for (int j = 0; j < 4; ++j) { const int n = (lane >> 3) + 8 * j; const LAS float* s = scr + (8 * c) * 33 + n;
        u32x4 o; o.x = cvt_pk_bf16(s[0 * 33], s[1 * 33]); o.y = cvt_pk_bf16(s[2 * 33], s[3 * 33]); o.z = cvt_pk_bf16(s[4 * 33], s[5 * 33]); o.w = cvt_pk_bf16(s[6 * 33], s[7 * 33]);
        if (n0 + n < N) *(u32x4*)(WT + (size_t)(drow0 < 0 ? proj_col(n0 + n) : drow0 + n) * D + k0 + 8 * c) = o; }
    LDS_WAIT(); asm volatile("" ::: "memory");
}
__device__ __forceinline__ void ln_row_f32_to_bf16(const float* xrow, const float* g, const float* b, bf16_t* orow, int lane) {
    const f32x4* xr = (const f32x4*)xrow + lane;
    f32x4 v[4]; float s = 0.f;
#pragma unroll
    for (int j = 0; j < 4; ++j) { v[j] = xr[64 * j]; s += (v[j].x + v[j].y) + (v[j].z + v[j].w); }
    const float mean = wave_sum(s) * (1.f / D); float s2 = 0.f;
#pragma unroll
    for (int j = 0; j < 4; ++j) { v[j] = v[j] - mean; s2 += (v[j].x * v[j].x + v[j].y * v[j].y) + (v[j].z * v[j].z + v[j].w * v[j].w); }
    const float rstd = 1.f / sqrtf(wave_sum(s2) * (1.f / D) + LN_EPS);
    u32x2* o8 = (u32x2*)orow + lane;
#pragma unroll
    for (int j = 0; j < 4; ++j) { const f32x4 gg = ((const f32x4*)g)[lane + 64 * j], bb = ((const f32x4*)b)[lane + 64 * j];
        u32x2 w; w.x = cvt_pk_bf16(v[j].x * rstd * gg.x + bb.x, v[j].y * rstd * gg.y + bb.y); w.y = cvt_pk_bf16(v[j].z * rstd * gg.z + bb.z, v[j].w * rstd * gg.w + bb.w);
        o8[64 * j] = w; }
}
__device__ __forceinline__ void transpose_item_f8(const float* W, int N, int k0, int n0, unsigned char* WT, int drow0, LAS float* scr, int lane, float scale) {
    const int kr = lane >> 3, nq = (lane & 7) * 4;
    f32x4 v[8];
#pragma unroll
    for (int i = 0; i < 8; ++i) v[i] = *(const f32x4*)(W + (size_t)(k0 + 8 * i + kr) * N + n0 + nq);
#pragma unroll
    for (int i = 0; i < 8; ++i) { LAS float* s = scr + (8 * i + kr) * 33 + nq; s[0] = v[i].x * scale; s[1] = v[i].y * scale; s[2] = v[i].z * scale; s[3] = v[i].w * scale; }
    LDS_WAIT(); asm volatile("" ::: "memory");
    const int c = lane & 7;
#pragma unroll
    for (int j = 0; j < 4; ++j) { const int n = (lane >> 3) + 8 * j; const LAS float* s = scr + (8 * c) * 33 + n;
        u32x2 o; o.x = cvt_fp8x4(s[0 * 33], s[1 * 33], s[2 * 33], s[3 * 33]); o.y = cvt_fp8x4(s[4 * 33], s[5 * 33], s[6 * 33], s[7 * 33]);
        *(u32x2*)(WT + (size_t)(drow0 + n) * W8_PITCH + k0 + 8 * c) = o; }
    LDS_WAIT(); asm volatile("" ::: "memory");
}
__device__ __forceinline__ void transpose_item_f6(const float* W, int N, int k0, int n0, unsigned char* WT, int drow0, LAS float* scr, int lane, float scale) {
    const int kr = lane >> 3, nq = (lane & 7) * 4;
    f32x4 v[8];
#pragma unroll
    for (int i = 0; i < 8; ++i) v[i] = *(const f32x4*)(W + (size_t)(k0 + 8 * i + kr) * N + n0 + nq);
#pragma unroll
    for (int i = 0; i < 8; ++i) { LAS float* s = scr + (8 * i + kr) * 33 + nq; s[0] = v[i].x * scale; s[1] = v[i].y * scale; s[2] = v[i].z * scale; s[3] = v[i].w * scale; }
    LDS_WAIT(); asm volatile("" ::: "memory");
    const int kb2 = lane >> 5, n = lane & 31; const LAS float* s = scr + (32 * kb2) * 33 + n;
    u32x16 blk;
#pragma unroll
    for (int j = 0; j < 16; ++j) blk[j] = cvt_pk_bf16(s[(2 * j) * 33], s[(2 * j + 1) * 33]);
    const int kk = k0 + 32 * kb2;
    store_fp6_block(WT + (size_t)(drow0 + n) * W8_PITCH + 128 * (kk >> 7), (kk >> 5) & 3, cvt_fp6x32(blk));
    LDS_WAIT(); asm volatile("" ::: "memory");
}
__device__ __forceinline__ void phase_prep(LAS unsigned char* lds, int vcu, int G) {
    const KP p = kparams();
    const int tid = opaque_tid(), lane = tid & 63, wave = __builtin_amdgcn_readfirstlane(tid >> 6);
    LAS float* scr = (LAS float*)(lds + wave * 16384);
    const int gw = vcu * NWAVES + wave, NGW = G * NWAVES;
    bf16_t* WinT = (bf16_t*)(p->ws + WS_WIN); bf16_t* WoutT = (bf16_t*)(p->ws + WS_WOUT);
    bf16_t* H = (bf16_t*)(p->ws + WS_H); bf16_t* PROJ = (bf16_t*)(p->ws + WS_PROJ);
    constexpr int NVIS = (NTOK + NMETA + 31) / 32;
    f32x4 vn[4][4];
#define P0_FETCH(mm0) do { _Pragma("unroll") for (int r = 0; r < 4; ++r) { const int m = (mm0) + r; \
            const f32x4* xr = (const f32x4*)(m < NTOK ? p->in[0] + (size_t)m * D : p->in[1] + (size_t)(m - NTOK) * D) + lane; \
            _Pragma("unroll") for (int j = 0; j < 4; ++j) vn[r][j] = xr[64 * j]; } } while (0)
    if (vcu < NVIS && 32 * vcu + 4 * wave < NTOK + NMETA) P0_FETCH(32 * vcu + 4 * wave);
    constexpr int I_IN = 16 * 97, I_OUT = 16 * 32;
    for (int it = gw; it < I_IN + I_OUT; it += NGW) {
        int r = it;
        if (r < I_IN) { const int kb = r / 97, nb = r % 97; transpose_item(p->in[4], NPROJ, 64 * kb, 32 * nb, WinT, -1, scr, lane); continue; } r -= I_IN;
        { const int kb = r / 32, nb = r % 32; transpose_item(p->in[14], D, 64 * kb, 32 * nb, WoutT, 32 * nb, scr, lane); }
    }
    const u32x4 z4 = (u32x4){0u, 0u, 0u, 0u};
    for (int r = gw; r < (LDP - NPROJ) + 240; r += NGW) {
        bf16_t* row = r < (LDP - NPROJ) ? WinT + (size_t)(NPROJ + r) * D : H + (size_t)(NTOK + NMETA + (r - (LDP - NPROJ))) * D;
        ((u32x4*)row)[lane] = z4; ((u32x4*)row)[lane + 64] = z4;
    }
    for (int r = gw; r < NB * 48; r += NGW) { u32x4* row = (u32x4*)(PROJ + (size_t)((r / 48) * LP + (r % 48)) * LDP); for (int j = lane; j < LDP / 8; j += 64) row[j] = z4; }
    for (int idx = gw * 64 + lane; idx < D * NE; idx += NGW * 64) { const float wv = p->in[17][idx]; const int k = idx >> 5, e = idx & 31;
        const unsigned hi = cvt_pk_bf16(wv, 0.f) & 0xffffu; const unsigned lo = cvt_pk_bf16(wv - bf2f(hi), 0.f) & 0xffffu;
        unsigned char* tb = p->ws + WS_RWT + (size_t)(k >> 9) * 66560 + 1040 * e + 2 * (k & 511);
        *(bf16_t*)tb = (bf16_t)hi; *(bf16_t*)(tb + 33280) = (bf16_t)lo; }
    __syncthreads();
    { const f32x4* gp = (const f32x4*)p->in[2]; const f32x4* bp = (const f32x4*)p->in[3];
      LAS unsigned char* tile = lds;
      LAS float* red = (LAS float*)(lds + 32 * 2064);
      f32x4 gg[4], bb[4];
#pragma unroll
      for (int j = 0; j < 4; ++j) { gg[j] = gp[lane + 64 * j]; bb[j] = bp[lane + 64 * j]; }
      bf16x8 wf[8];
      { const int col = lane & 31, hh = lane >> 5; const int oc = col < 16 ? 1536 + col : 3088 + (col - 16);
#pragma unroll
        for (int sk = 0; sk < 8; ++sk) { float t[8];
#pragma unroll
            for (int j = 0; j < 8; ++j) t[j] = col < 24 ? p->in[4][(size_t)(128 * wave + 16 * sk + 8 * hh + j) * NPROJ + oc] : 0.f;
            wf[sk] = __builtin_bit_cast(bf16x8, (u32x4){cvt_pk_bf16(t[0], t[1]), cvt_pk_bf16(t[2], t[3]), cvt_pk_bf16(t[4], t[5]), cvt_pk_bf16(t[6], t[7])}); } }
#pragma unroll 1
      for (int vis = vcu; vis < NVIS; vis += G) {
        const int m0 = 32 * vis + 4 * wave; const bool valid = m0 < NTOK + NMETA;
        f32x4 v[4][4];
#pragma unroll
        for (int r = 0; r < 4; ++r)
#pragma unroll
            for (int j = 0; j < 4; ++j) v[r][j] = vn[r][j];
        if (vis + G < NVIS && m0 + 32 * G < NTOK + NMETA) P0_FETCH(m0 + 32 * G);
        if (valid) {
#pragma unroll
          for (int r = 0; r < 4; ++r) {
            float s = 0.f, s2 = 0.f;
#pragma unroll
            for (int j = 0; j < 4; ++j) { s += (v[r][j].x + v[r][j].y) + (v[r][j].z + v[r][j].w); s2 += (v[r][j].x * v[r][j].x + v[r][j].y * v[r][j].y) + (v[r][j].z * v[r][j].z + v[r][j].w * v[r][j].w); }
            s = wave_sum(s); s2 = wave_sum(s2);
            const float mean = s * (1.f / D), rstd = fast_rsq(fmaxf(s2 * (1.f / D) - mean * mean, 0.f) + LN_EPS);
#pragma unroll
            for (int j = 0; j < 4; ++j) v[r][j] = v[r][j] - mean;
            u32x2* o8 = (u32x2*)(H + (size_t)(m0 + r) * D) + lane;
            LAS u32x2* t8 = (LAS u32x2*)(tile + 2064 * (4 * wave + r)) + lane;
#pragma unroll
            for (int j = 0; j < 4; ++j) { u32x2 w; w.x = cvt_pk_bf16(v[r][j].x * rstd * gg[j].x + bb[j].x, v[r][j].y * rstd * gg[j].y + bb[j].y);
                w.y = cvt_pk_bf16(v[r][j].z * rstd * gg[j].z + bb[j].z, v[r][j].w * rstd * gg[j].w + bb[j].w); o8[64 * j] = w; t8[64 * j] = w; }
          } }
        __syncthreads();
        { f32x16 acc;
#pragma unroll
          for (int r = 0; r < 16; ++r) acc[r] = 0.f;
          const LAS unsigned char* ap = tile + 2064 * (lane & 31) + 2 * (128 * wave + 8 * (lane >> 5));
#pragma unroll
          for (int sk = 0; sk < 8; ++sk) acc = __builtin_amdgcn_mfma_f32_32x32x16_bf16(*(const LAS bf16x8*)(ap + 32 * sk), wf[sk], acc, 0, 0, 0);
#pragma unroll
          for (int r = 0; r < 16; ++r) red[(wave * 16 + r) * 64 + lane] = acc[r]; }
        __syncthreads();
#pragma unroll
        for (int q = 0; q < 2; ++q) { const int o = tid + 512 * q, reg = o >> 6, l = o & 63, col = l & 31;
            float sum = 0.f;
#pragma unroll
            for (int ww = 0; ww < 8; ++ww) sum += red[ww * 1024 + o];
            const int m = 32 * vis + (reg & 3) + 8 * (reg >> 2) + 4 * (l >> 5);
            if (col < 24) { const int pc = col < 16 ? C_A1 + col : C_DT + (col - 16); const bf16_t hv = f2bf(sum);
                if (m < NTOK) PROJ[(size_t)(m + 64 * ((m >> 11) + 1)) * LDP + pc] = hv;
                else if (m < NTOK + NMETA) { for (int b = 0; b < NB; ++b) PROJ[(size_t)(b * LP + 48 + (m - NTOK)) * LDP + pc] = hv; } } }
      } }
#undef P0_FETCH
}

__device__ __forceinline__ f32x16 mfma32(bf16x8 a, bf16x8 b, f32x16 c) { return __builtin_amdgcn_mfma_f32_32x32x16_bf16(a, b, c, 0, 0, 0); }
__device__ __forceinline__ int crow(int reg, int h) { return (reg & 3) + 8 * (reg >> 2) + 4 * h; }
__device__ __forceinline__ int swz(int row) { return ((row & 3) << 2) | ((row >> 2) & 3); }
template <int PITCH> __device__ __forceinline__ int img_off(int row, int col) { return PITCH * row + 16 * ((col >> 3) ^ swz(row)) + 2 * (col & 7); }
template <int PITCH> __device__ __forceinline__ bf16x8 tr_frag(LAS unsigned char* img, int cb, int ks, int lane) {
    const int h = lane >> 5, blk = (lane >> 4) & 1, q = (lane & 15) >> 2, p2 = lane & 3;
    const int row = 16 * ks + 8 * h + q, col = cb + 16 * blk + 4 * p2;
    const s16x4 lo = __builtin_amdgcn_ds_read_tr16_b64_v4i16((LAS s16x4*)(img + img_off<PITCH>(row, col)));
    const s16x4 hi = __builtin_amdgcn_ds_read_tr16_b64_v4i16((LAS s16x4*)(img + img_off<PITCH>(row + 4, col)));
    return __builtin_shufflevector(lo, hi, 0, 1, 2, 3, 4, 5, 6, 7);
}
template <int PITCH> __device__ __forceinline__ bf16x8 rowp_frag(LAS unsigned char* img, int row, int c1) {
    const s16x4 lo = *(const LAS s16x4*)(img + img_off<PITCH>(row, c1)), hi = *(const LAS s16x4*)(img + img_off<PITCH>(row, c1 + 8));
    return __builtin_shufflevector(lo, hi, 0, 1, 2, 3, 4, 5, 6, 7);
}
#define PACK8(x, s) __builtin_bit_cast(bf16x8, (u32x4){cvt_pk_bf16((x)[8 * (s)], (x)[8 * (s) + 1]), cvt_pk_bf16((x)[8 * (s) + 2], (x)[8 * (s) + 3]), cvt_pk_bf16((x)[8 * (s) + 4], (x)[8 * (s) + 5]), cvt_pk_bf16((x)[8 * (s) + 6], (x)[8 * (s) + 7])})
__device__ __forceinline__ float tr_reduce32(const float (&v)[32], int lane) {
    float a[16], b[8], c[4], d[2];
    { const bool hi = (lane & 16) != 0;
#pragma unroll
      for (int r = 0; r < 16; ++r) { const float keep = hi ? v[r + 16] : v[r], send = hi ? v[r] : v[r + 16]; a[r] = keep + __shfl_xor(send, 16); } }
    { const bool hi = (lane & 8) != 0;
#pragma unroll
      for (int r = 0; r < 8; ++r) { const float keep = hi ? a[r + 8] : a[r], send = hi ? a[r] : a[r + 8]; b[r] = keep + __shfl_xor(send, 8); } }
    { const bool hi = (lane & 4) != 0;
#pragma unroll
      for (int r = 0; r < 4; ++r) { const float keep = hi ? b[r + 4] : b[r], send = hi ? b[r] : b[r + 4]; c[r] = keep + __shfl_xor(send, 4); } }
    { const bool hi = (lane & 2) != 0;
#pragma unroll
      for (int r = 0; r < 2; ++r) { const float keep = hi ? c[r + 2] : c[r], send = hi ? c[r] : c[r + 2]; d[r] = keep + __shfl_xor(send, 2); } }
    { const bool hi = (lane & 1) != 0; const float keep = hi ? d[1] : d[0], send = hi ? d[0] : d[1]; return keep + __shfl_xor(send, 1); }
}
constexpr int MX_RAW = 0, MX_OUT = 98304, MX_AUX = 131072;
constexpr size_t WS_XA = 834 * MiB;
constexpr size_t WS_XW = 10 * MiB;
constexpr size_t WS_KD = 76 * MiB;
constexpr size_t WS_DECG = 109 * MiB;
constexpr size_t WS_DECS = 112 * MiB;
static_assert(WS_XA + (size_t)NB * LP * 1024 * 2 <= 1024 * MiB && WS_XW + (size_t)NB * LP * 512 * 2 <= WS_KD && WS_KD + (size_t)NB * LP * 256 * 2 <= WS_DECG && WS_DECG + (size_t)NB * NCH * 256 * 4 <= WS_DECS && WS_DECS + (size_t)NB * NCH * 8 * 4 <= WS_TLIST, "pre-pass buffers");

__device__ __forceinline__ void convert_batches(LAS unsigned char* lds, int maxb, unsigned per);
__device__ __forceinline__ void phase_pre(LAS unsigned char* lds, int vcu, int G) {
    const KP p = kparams();
    const int tid = opaque_tid(), lane = tid & 63, w = __builtin_amdgcn_readfirstlane(tid >> 6);
    const bf16_t* PROJ = (const bf16_t*)(p->ws + WS_PROJ);
    bf16_t* XA = (bf16_t*)(p->ws + WS_XA); float* WSB = (float*)(p->ws + WS_XW); bf16_t* KD = (bf16_t*)(p->ws + WS_KD);
    float* DECG = (float*)(p->ws + WS_DECG); float* DECS = (float*)(p->ws + WS_DECS);
    LAS unsigned char* raw_ = lds + MX_RAW; LAS unsigned char* xw_ = lds + MX_OUT;
    LAS unsigned char* dtraw_ = lds + MX_AUX; LAS float* wS_ = (LAS float*)(lds + MX_AUX + 1024); LAS unsigned char* a1raw_ = lds + MX_AUX + 2048; LAS float* qtot_ = (LAS float*)(lds + MX_AUX + 6144);
    const int prow_ = tid >> 3, c7_ = tid & 7, jj_ = tid & 127, qd = tid >> 7;
    u32x4 pf[10], pfa, pfdt; unsigned short ph3 = 0, ph2 = 0, ph1 = 0;
#define PRE_FETCH(it_) do { const int b_ = (it_) / (NCH * 2), r_ = (it_) % (NCH * 2), c_ = r_ >> 1, x_ = r_ & 1; const size_t R0_ = (size_t)b_ * LP + 64 * c_; \
        const bf16_t* rp = PROJ + (R0_ + prow) * LDP + 8 * c7; \
        _Pragma("unroll") for (int k = 0; k < 10; ++k) { const int col = k < 4 ? C_XBC + 256 * x_ + 64 * k : (k < 6 ? C_XBC + 512 + 128 * x_ + 64 * (k - 4) : (k < 8 ? C_XBC + 768 + 128 * x_ + 64 * (k - 6) : C_K + 128 * x_ + 64 * (k - 8))); \
            pf[k] = *(const u32x4*)(rp + col); } \
        if (tid < 128) pfa = *(const u32x4*)(PROJ + (R0_ + (tid >> 1)) * LDP + C_A1 + 8 * (tid & 1)); \
        if (tid < 64) pfdt = *(const u32x4*)(PROJ + (R0_ + tid) * LDP + C_DT); \
        { const int cch_ = tid < 256 ? 256 * x_ + tid : (tid < 384 ? 512 + 128 * x_ + (tid - 256) : 768 + 128 * x_ + (tid - 384)); \
          if (c_ > 0) { const bf16_t* hq = PROJ + R0_ * LDP + C_XBC + cch_; ph3 = *(hq - 3 * (size_t)LDP); ph2 = *(hq - 2 * (size_t)LDP); ph1 = *(hq - (size_t)LDP); } else { ph3 = 0; ph2 = 0; ph1 = 0; } } } while (0)
    constexpr int NIT = NB * NCH * 2;
    const int nfull = NIT / G, nrem = NIT % G;
    const bool odd = (vcu & 1) != 0, extra = !odd && (vcu >> 1) < nrem;
    const int nmine = nfull + (extra ? 1 : 0);
#define PRE_ITEM(j_) ((j_) < nfull ? vcu + G * (j_) : nfull * G + (vcu >> 1))
    if (odd) { convert_batches(lds, 1, 4u); __syncthreads(); }
    const int fhh = w >> 2, cbb = w & 3, l31 = lane & 31, lhh = lane >> 5;
    bf16x8 wa2f[2]; float bav[2];
#pragma unroll
    for (int x_ = 0; x_ < 2; ++x_) { float t[8];
#pragma unroll
        for (int j = 0; j < 8; ++j) t[j] = p->in[5][(8 * lhh + j) * 256 + 128 * x_ + 32 * cbb + l31];
        wa2f[x_] = __builtin_bit_cast(bf16x8, (u32x4){cvt_pk_bf16(t[0], t[1]), cvt_pk_bf16(t[2], t[3]), cvt_pk_bf16(t[4], t[5]), cvt_pk_bf16(t[6], t[7])});
        bav[x_] = p->in[6][128 * x_ + 32 * cbb + l31]; }
    float cwv[2][5], dtbv[2], alogv[2];
#pragma unroll
    for (int x_ = 0; x_ < 2; ++x_) { const int cch_ = tid < 256 ? 256 * x_ + tid : (tid < 384 ? 512 + 128 * x_ + (tid - 256) : 768 + 128 * x_ + (tid - 384));
#pragma unroll
        for (int q_ = 0; q_ < 4; ++q_) cwv[x_][q_] = p->in[8][q_ * 1024 + cch_];
        cwv[x_][4] = p->in[9][cch_]; dtbv[x_] = p->in[10][4 * x_ + (w & 3)]; alogv[x_] = -__expf(p->in[11][4 * x_ + (w & 3)]); }
    if (nmine > 0) { const int prow = prow_, c7 = c7_; const int it0_ = PRE_ITEM(0); PRE_FETCH(it0_); }
    for (int jit = 0; jit < nmine; ++jit) {
        const int it = PRE_ITEM(jit);
        int oz = 0; asm volatile("" : "+v"(oz));
        LAS unsigned char* const raw = raw_ + oz; LAS unsigned char* const xw = xw_ + oz; LAS unsigned char* const dtraw = dtraw_ + oz; LAS float* const wS = wS_ + oz;
        LAS unsigned char* const a1raw = a1raw_ + oz; LAS float* const qtot = qtot_ + oz;
        const int prow = prow_ + oz, c7 = c7_ + oz, jj = jj_ + oz;
        const int b = it / (NCH * 2), r = it % (NCH * 2), c = r >> 1, x = r & 1;
        const size_t R0 = (size_t)b * LP + 64 * c;
#pragma unroll
        for (int k = 0; k < 8; ++k) *(LAS u32x4*)(raw + 1536 * prow + 16 * ((8 * k + c7) ^ swz(prow))) = pf[k];
#pragma unroll
        for (int k = 0; k < 2; ++k) *(LAS u32x4*)(raw + 1536 * prow + 16 * ((64 + 8 * k + c7) ^ swz(prow))) = pf[8 + k];
        if (tid < 64) *(LAS u32x4*)(dtraw + 16 * tid) = pfdt;
        if (tid < 128) *(LAS u32x4*)(a1raw + 16 * tid) = pfa;
        float xm3 = bf2f(ph3), xm2 = bf2f(ph2), xm1 = bf2f(ph1);
        __syncthreads();
        if (jit + 1 < nmine) { const int itn_ = PRE_ITEM(jit + 1); PRE_FETCH(itn_); }
        const int kcol = 128 * x + 32 * cbb + l31;
        float cl[16];
        { f32x16 gacc;
#pragma unroll
          for (int r = 0; r < 16; ++r) gacc[r] = 0.f;
          const bf16x8 af = *(const LAS bf16x8*)(a1raw + 32 * (32 * fhh + l31) + 16 * lhh);
          gacc = __builtin_amdgcn_mfma_f32_32x32x16_bf16(af, x ? wa2f[1] : wa2f[0], gacc, 0, 0, 0);
          const float ba = x ? bav[1] : bav[0];
          float bs[4], ob[4];
#pragma unroll
          for (int j = 0; j < 4; ++j) { float run = 0.f;
#pragma unroll
              for (int e = 0; e < 4; ++e) { const int i = 32 * fhh + 8 * j + 4 * lhh + e; const float gq = gacc[4 * j + e] + ba;
                  float la = (fminf(gq, 0.f) - fast_log(1.f + fast_exp(-fabsf(gq)))) * (1.0f / 16.0f);
                  if (c == 0 && i < 48) la = 0.f;
                  run += la; cl[4 * j + e] = run; }
              bs[j] = run; }
#pragma unroll
          for (int j = 0; j < 4; ++j) ob[j] = __shfl_xor(bs[j], 32);
          float off = 0.f;
#pragma unroll
          for (int j = 0; j < 4; ++j) { const float before = off + (lhh ? ob[j] : 0.f);
#pragma unroll
              for (int e = 0; e < 4; ++e) cl[4 * j + e] += before;
              off += bs[j] + ob[j]; }
          if (lhh == 0) qtot[fhh * 128 + 32 * cbb + l31] = off; }
        if (w < 4) {
            const float rawdt = bf2f(*(const LAS bf16_t*)(dtraw + 16 * lane + 2 * (4 * x + w))) + (x ? dtbv[1] : dtbv[0]);
            float dt = fmaxf(rawdt, 0.f) + fast_log(1.f + fast_exp(-fabsf(rawdt)));
            if (c == 0 && lane < 48) dt = 0.f;
            float cum = dt * (x ? alogv[1] : alogv[0]);
            cum = wave_scan_incl(cum);
            const float total = __builtin_bit_cast(float, __builtin_amdgcn_readlane(__builtin_bit_cast(int, cum), 63));
            wS[w * 64 + lane] = fast_exp(total - cum) * dt;
            if (lane == 0) DECS[((size_t)b * NCH + c) * 8 + 4 * x + w] = fast_exp(total);
        }
        __syncthreads();
        { const int colg = 32 * cbb + l31; const float h0 = qtot[colg], h1 = qtot[128 + colg];
          const float total = h0 + h1, offs = fhh ? h0 : 0.f;
          const int cbyte = 2 * (colg & 7), cchunk = (512 + colg) >> 3;
#pragma unroll
          for (int r = 0; r < 16; ++r) { const int j = r >> 2, e = r & 3; const int frame = 32 * fhh + 8 * j + 4 * lhh + e;
              LAS bf16_t* kp = (LAS bf16_t*)(raw + 1536 * frame + 16 * (cchunk ^ ((e << 2) | ((2 * j + lhh) & 3))) + cbyte);
              *kp = f2bf(bf2f(*kp) * fast_exp(total - (offs + cl[r]))); }
          if (fhh == 0 && lhh == 0) DECG[((size_t)b * NCH + c) * 256 + kcol] = fast_exp(total); }
        { const int cch = tid < 256 ? 256 * x + tid : (tid < 384 ? 512 + 128 * x + (tid - 256) : 768 + 128 * x + (tid - 384));
          const float cw0 = x ? cwv[1][0] : cwv[0][0], cw1 = x ? cwv[1][1] : cwv[0][1], cw2 = x ? cwv[1][2] : cwv[0][2], cw3 = x ? cwv[1][3] : cwv[0][3], cb = x ? cwv[1][4] : cwv[0][4];
          const int to = tid + oz; const int tb = 16 * (to >> 3) + 2 * (to & 7);
#pragma unroll 1
          for (int i0 = 0; i0 < 64; i0 += 16) {
            LAS unsigned char* rg = raw + 1536 * i0;
#pragma unroll
            for (int f = 0; f < 16; ++f) { LAS bf16_t* ep = (LAS bf16_t*)(rg + 1536 * f + (tb ^ (16 * (((f & 3) << 2) | ((f >> 2) & 3)))));
                const float xin = bf2f(*ep);
                const float v = cw0 * xm3 + cw1 * xm2 + cw2 * xm1 + cw3 * xin + cb; xm3 = xm2; xm2 = xm1; xm1 = xin;
                *ep = f2bf(silu_f(v)); }
          } }
        __syncthreads();
        if (tid < 256) WSB[((size_t)(b * NCH + c) * 2 + x) * 256 + tid] = wS[tid];
        { bf16_t* xa = XA + (R0 + prow) * 1024 + 8 * c7; bf16_t* kd = KD + (R0 + prow) * 256 + 128 * x + 8 * c7;
#pragma unroll
          for (int k = 0; k < 8; ++k) { const int col = k < 4 ? 256 * x + 64 * k : (k < 6 ? 512 + 128 * x + 64 * (k - 4) : 768 + 128 * x + 64 * (k - 6));
              *(u32x4*)(xa + col) = *(const LAS u32x4*)(raw + 1536 * prow + 16 * ((8 * k + c7) ^ swz(prow))); }
#pragma unroll
          for (int k = 0; k < 2; ++k) *(u32x4*)(kd + 64 * k) = *(const LAS u32x4*)(raw + 1536 * prow + 16 * ((64 + 8 * k + c7) ^ swz(prow))); }
        __syncthreads();
    }
#undef PRE_FETCH
#undef PRE_ITEM
    if (!odd && !extra) convert_batches(lds, 1, 4u);
}

__device__ __forceinline__ void gla_unit(LAS unsigned char* lds, int b, int hp) {
    const KP p = kparams();
    const int tid = opaque_tid(), lane = tid & 63, w = __builtin_amdgcn_readfirstlane(tid >> 6);
    const bf16_t* PROJ = (const bf16_t*)(p->ws + WS_PROJ); const bf16_t* KD = (const bf16_t*)(p->ws + WS_KD); const float* DECG = (const float*)(p->ws + WS_DECG); bf16_t* MIX = (bf16_t*)(p->ws + WS_MIX);
    LAS unsigned char* raw_ = lds + MX_RAW;
    LAS unsigned char* outI_ = lds + MX_OUT;
    LAS float* dec_ = (LAS float*)(lds + MX_AUX);
    LAS float* rsq = dec_ + 128;
    LAS float* gnS = rsq + 512;
    const int hl = w >> 2, ps = (w & 3) * 32, lh = lane >> 5, l31 = lane & 31;
    const int prow_ = tid >> 3, c7_ = tid & 7;
    if (tid < 256) gnS[tid] = p->in[7][256 * hp + tid];
    f32x16 S[2];
#pragma unroll
    for (int mt = 0; mt < 2; ++mt)
#pragma unroll
        for (int r = 0; r < 16; ++r) S[mt][r] = 0.f;
    u32x4 pf[12]; float pfd = 0.f;
#define GLA_FETCH(cc) do { const size_t rw_ = (size_t)b * LP + 64 * (cc) + prow; const bf16_t* rp = PROJ + rw_ * LDP + 8 * c7; const bf16_t* kp_ = KD + rw_ * 256 + 128 * hp + 8 * c7; \
        _Pragma("unroll") for (int k = 0; k < 12; ++k) { \
            if (k == 2 || k == 3) pf[k] = *(const u32x4*)(kp_ + 64 * (k - 2)); \
            else { const int col = k < 2 ? C_Q + 128 * hp + 64 * k : (k < 8 ? C_V + 256 * hp + 64 * (k - 4) : C_OG + 256 * hp + 64 * (k - 8)); pf[k] = *(const u32x4*)(rp + col); } } \
        if (tid < 128) pfd = DECG[((size_t)b * NCH + (cc)) * 256 + 128 * hp + tid]; } while (0)
    { const int prow = prow_, c7 = c7_; GLA_FETCH(0); }
#define GLA_COPY_OUT(dst_, outI_p, prow_v, c7_v) do { \
        float rnh[2]; \
        _Pragma("unroll") for (int h_ = 0; h_ < 2; ++h_) { const float tot_ = (rsq[(h_ * 4 + 0) * 64 + (prow_v)] + rsq[(h_ * 4 + 1) * 64 + (prow_v)]) + (rsq[(h_ * 4 + 2) * 64 + (prow_v)] + rsq[(h_ * 4 + 3) * 64 + (prow_v)]); \
            rnh[h_] = 0.125f * fast_rsq(tot_ * (1.0f / 128.0f) + RMS_EPS); } \
        _Pragma("unroll") for (int k = 0; k < 4; ++k) { const int ch = 8 * k + (c7_v); const u32x4 pv = *(const LAS u32x4*)((outI_p) + 512 * (prow_v) + 16 * (ch ^ swz(prow_v))); \
            const f32x2_t r2 = {rnh[k >> 1], rnh[k >> 1]}; u32x4 ov; \
            _Pragma("unroll") for (int e = 0; e < 4; ++e) { const f32x2_t t_ = bf2f2(pv[e]) * r2; ov[e] = cvt_pk_bf16(t_.x, t_.y); } \
            *(u32x4*)((dst_) + 8 * ch) = ov; } } while (0)
    for (int c = 0; c < NCH; ++c) {
        int oz = 0; asm volatile("" : "+v"(oz));
        LAS unsigned char* const raw = raw_ + oz; LAS unsigned char* const outI = outI_ + oz; LAS float* const dec = dec_ + oz;
        const int prow = prow_ + oz, c7 = c7_ + oz;
        if (c >= 2) { bf16_t* dst = MIX + ((size_t)b * SEQ + 64 * (c - 2) + prow) * D + 256 * hp;
            GLA_COPY_OUT(dst, outI, prow, c7); }
#pragma unroll
        for (int k = 0; k < 12; ++k) *(LAS u32x4*)(raw + 1536 * prow + 16 * ((8 * k + c7) ^ swz(prow))) = pf[k];
        if (tid < 128) dec[tid] = pfd;
        __syncthreads();
        if (c + 1 < NCH) GLA_FETCH(c + 1);
#pragma unroll
        for (int mt = 0; mt < 2; ++mt)
#pragma unroll
            for (int r = 0; r < 16; ++r) S[mt][r] *= dec[hl * 64 + 32 * mt + crow(r, lh)];
#pragma unroll
        for (int ks = 0; ks < 4; ++ks) {
            const bf16x8 bv = tr_frag<1536>(raw, 256 + 128 * hl + ps, ks, lane);
#pragma unroll
            for (int mt = 0; mt < 2; ++mt) { const bf16x8 av = tr_frag<1536>(raw, 128 + 64 * hl + 32 * mt, ks, lane); S[mt] = mfma32(av, bv, S[mt]); }
            __builtin_amdgcn_sched_barrier(0);
        }
        if (c > 0) {
            f32x16 Z[2];
#pragma unroll
            for (int mt = 0; mt < 2; ++mt)
#pragma unroll
                for (int r = 0; r < 16; ++r) Z[mt][r] = 0.f;
#pragma unroll
            for (int ms = 0; ms < 2; ++ms)
#pragma unroll
                for (int s = 0; s < 2; ++s) {
                    const bf16x8 av = PACK8(S[ms], s);
#pragma unroll
                    for (int mt = 0; mt < 2; ++mt) { const bf16x8 bv = rowp_frag<1536>(raw, 32 * mt + l31, 64 * hl + 32 * ms + 16 * s + 4 * lh); Z[mt] = mfma32(av, bv, Z[mt]); }
                    __builtin_amdgcn_sched_barrier(0);
                }
#pragma unroll
            for (int mt = 0; mt < 2; ++mt) { float ssq = 0.f;
#pragma unroll
                for (int r = 0; r < 16; ++r) ssq += Z[mt][r] * Z[mt][r];
                ssq += __shfl_xor(ssq, 32);
                if (lh == 0) rsq[(hl * 4 + (w & 3)) * 64 + 32 * mt + l31] = ssq * (0.125f * 0.125f); }
#pragma unroll
            for (int mt = 0; mt < 2; ++mt) { const int i = 32 * mt + l31;
                const float rn = 1.0f;
#pragma unroll
                for (int g4 = 0; g4 < 4; ++g4) { const int p0 = 128 * hl + ps + 8 * g4 + 4 * lh;
                    const u32x2 og2 = *(const LAS u32x2*)(raw + img_off<1536>(i, 512 + p0));
                    const f32x4 gv = *(const LAS f32x4*)(gnS + p0);
                    u32x2 o2;
                    const f32x2_t rn2 = {rn, rn};
                    const f32x2_t q0 = (f32x2_t){Z[mt][4 * g4 + 0], Z[mt][4 * g4 + 1]} * rn2 * (f32x2_t){gv.x, gv.y} * silu_f2(bf2f2(og2.x));
                    const f32x2_t q1 = (f32x2_t){Z[mt][4 * g4 + 2], Z[mt][4 * g4 + 3]} * rn2 * (f32x2_t){gv.z, gv.w} * silu_f2(bf2f2(og2.y));
                    o2.x = cvt_pk_bf16(q0.x, q0.y); o2.y = cvt_pk_bf16(q1.x, q1.y);
                    *(LAS u32x2*)(outI + img_off<512>(i, p0)) = o2; } }
        }
        __syncthreads();
    }
    { const int t2 = opaque_tid(); const int prow = t2 >> 3, c7 = t2 & 7; LAS unsigned char* const outI = outI_;
      bf16_t* dst = MIX + ((size_t)b * SEQ + 64 * (NCH - 2) + prow) * D + 256 * hp;
      GLA_COPY_OUT(dst, outI, prow, c7); }
#undef GLA_COPY_OUT
#undef GLA_FETCH
}

__device__ __forceinline__ void ssd_unit(LAS unsigned char* lds, int b, int g, int par) {
    const KP p = kparams();
    const int tid = opaque_tid(), lane = tid & 63, w = __builtin_amdgcn_readfirstlane(tid >> 6);
    const bf16_t* PROJ = (const bf16_t*)(p->ws + WS_PROJ); const bf16_t* XA = (const bf16_t*)(p->ws + WS_XA); const float* WSB = (const float*)(p->ws + WS_XW);
    const float* DECS = (const float*)(p->ws + WS_DECS); bf16_t* MIX = (bf16_t*)(p->ws + WS_MIX);
    LAS unsigned char* raw_ = lds + MX_RAW;
    LAS unsigned char* xw_ = lds + MX_OUT;
    LAS float* decS_ = (LAS float*)(lds + MX_AUX);
    LAS float* rsq = decS_ + 16;
    LAS float* ngS = rsq + 512;
    const int hl = w >> 1, ps = (w & 1) * 32, lh = lane >> 5, l31 = lane & 31;
    const int hh = 4 * g + hl;
    const int prow_ = tid >> 3, c7_ = tid & 7;
    const float Dp = p->in[12][hh];
    if (tid < 256) ngS[tid] = p->in[13][256 * g + tid];
    f32x16 S[4];
#pragma unroll
    for (int mt = 0; mt < 4; ++mt)
#pragma unroll
        for (int r = 0; r < 16; ++r) S[mt][r] = 0.f;
    u32x4 pf[12]; float pwv[4]; float pfd = 0.f;
#define SSD_FETCH(cc) do { const size_t rw_ = (size_t)b * LP + 64 * (cc) + prow; const bf16_t* xa = XA + rw_ * 1024 + 8 * c7; const bf16_t* zp = PROJ + rw_ * LDP + 8 * c7 + C_Z + 256 * g; \
        const float* wq = WSB + ((size_t)(b * NCH + (cc)) * 2 + g) * 256 + prow; \
        pf[4] = *(const u32x4*)(xa + 512 + 128 * g); pf[5] = *(const u32x4*)(xa + 512 + 128 * g + 64); \
        _Pragma("unroll") for (int k = 0; k < 4; ++k) { pf[k] = *(const u32x4*)(xa + 256 * g + 64 * k); pwv[k] = wq[64 * k]; } \
        if ((cc) > 0 && (((cc) & 1) == par)) {                         \
            pf[6] = *(const u32x4*)(xa + 768 + 128 * g); pf[7] = *(const u32x4*)(xa + 768 + 128 * g + 64); \
            _Pragma("unroll") for (int k = 0; k < 4; ++k) pf[8 + k] = *(const u32x4*)(zp + 64 * k); } \
        if (tid < 4) pfd = DECS[((size_t)b * NCH + (cc)) * 8 + 4 * g + tid]; } while (0)
    { const int prow = prow_, c7 = c7_; SSD_FETCH(0); }
#define SSD_COPY_OUT(dst_, raw_p, prow_v, c7_v) do { \
        float tot_ = 0.f; \
        _Pragma("unroll") for (int ww = 0; ww < 8; ++ww) tot_ += rsq[ww * 64 + (prow_v)]; \
        const float rn_ = fast_rsq(tot_ * (1.0f / 256.0f) + RMS_EPS); const f32x2_t r2 = {rn_, rn_}; \
        _Pragma("unroll") for (int k = 0; k < 4; ++k) { const int ch = 8 * k + (c7_v); const u32x4 pv = *(const LAS u32x4*)((raw_p) + 1536 * (prow_v) + 16 * (ch ^ swz(prow_v))); u32x4 ov; \
            _Pragma("unroll") for (int e = 0; e < 4; ++e) { const f32x2_t t_ = bf2f2(pv[e]) * r2; ov[e] = cvt_pk_bf16(t_.x, t_.y); } \
            *(u32x4*)((dst_) + 8 * ch) = ov; } } while (0)
    for (int c = 0; c < NCH; ++c) {
        int oz = 0; asm volatile("" : "+v"(oz));
        LAS unsigned char* const raw = raw_ + oz; LAS unsigned char* const xw = xw_ + oz; LAS float* const decS = decS_ + oz;
        const int prow = prow_ + oz, c7 = c7_ + oz;
        const bool dout = c > 0 && ((c & 1) == par);
        if (c >= 2 && !dout) { bf16_t* dst = MIX + ((size_t)b * SEQ + 64 * (c - 2) + prow) * D + 512 + 256 * g;
            SSD_COPY_OUT(dst, raw, prow, c7); }
#pragma unroll
        for (int k = 0; k < 12; ++k) if (dout || k == 4 || k == 5) *(LAS u32x4*)(raw + 1536 * prow + 16 * ((8 * k + c7) ^ swz(prow))) = pf[k];
#pragma unroll
        for (int k = 0; k < 4; ++k) { const f32x2_t w2 = {pwv[k], pwv[k]}; u32x4 xo;
#pragma unroll
            for (int e = 0; e < 4; ++e) { const f32x2_t t_ = bf2f2(pf[k][e]) * w2; xo[e] = cvt_pk_bf16(t_.x, t_.y); }
            *(LAS u32x4*)(xw + 512 * prow + 16 * ((8 * k + c7) ^ swz(prow))) = xo; }
        if (tid < 4) decS[tid] = pfd;
        __syncthreads();
        if (c + 1 < NCH) SSD_FETCH(c + 1);
        { const float dc = decS[hl];
#pragma unroll
          for (int mt = 0; mt < 4; ++mt)
#pragma unroll
              for (int r = 0; r < 16; ++r) S[mt][r] *= dc; }
#pragma unroll
        for (int ks = 0; ks < 4; ++ks) {
            const bf16x8 bv = tr_frag<512>(xw, 64 * hl + ps, ks, lane);
#pragma unroll
            for (int mt = 0; mt < 4; ++mt) { const bf16x8 av = tr_frag<1536>(raw, 256 + 32 * mt, ks, lane); S[mt] = mfma32(av, bv, S[mt]); }
            __builtin_amdgcn_sched_barrier(0);
        }
        if (dout) {
            f32x16 Y[2];
#pragma unroll
            for (int mt = 0; mt < 2; ++mt)
#pragma unroll
                for (int r = 0; r < 16; ++r) Y[mt][r] = 0.f;
#pragma unroll
            for (int ms = 0; ms < 4; ++ms)
#pragma unroll
                for (int s = 0; s < 2; ++s) {
                    const bf16x8 av = PACK8(S[ms], s);
#pragma unroll
                    for (int mt = 0; mt < 2; ++mt) { const bf16x8 bv = rowp_frag<1536>(raw, 32 * mt + l31, 384 + 32 * ms + 16 * s + 4 * lh); Y[mt] = mfma32(av, bv, Y[mt]); }
                    __builtin_amdgcn_sched_barrier(0);
                }
#pragma unroll
            for (int mt = 0; mt < 2; ++mt) { const int i = 32 * mt + l31; float ssq = 0.f;
#pragma unroll
                for (int g4 = 0; g4 < 4; ++g4) { const int p0 = 64 * hl + ps + 8 * g4 + 4 * lh;
                    const u32x2 x2 = *(const LAS u32x2*)(raw + img_off<1536>(i, p0)), z2 = *(const LAS u32x2*)(raw + img_off<1536>(i, 512 + p0));
                    const f32x2_t Dp2 = {Dp, Dp};
                    const f32x2_t w01 = ((f32x2_t){Y[mt][4 * g4 + 0], Y[mt][4 * g4 + 1]} + bf2f2(x2.x) * Dp2) * silu_f2(bf2f2(z2.x));
                    const f32x2_t w23 = ((f32x2_t){Y[mt][4 * g4 + 2], Y[mt][4 * g4 + 3]} + bf2f2(x2.y) * Dp2) * silu_f2(bf2f2(z2.y));
                    const float v0 = w01.x, v1 = w01.y, v2 = w23.x, v3 = w23.y;
                    ssq += (v0 * v0 + v1 * v1) + (v2 * v2 + v3 * v3);
                    const f32x4 gv = *(const LAS f32x4*)(ngS + p0);
                    u32x2 o2; o2.x = cvt_pk_bf16(v0 * gv.x, v1 * gv.y); o2.y = cvt_pk_bf16(v2 * gv.z, v3 * gv.w);
                    *(LAS u32x2*)(raw + img_off<1536>(i, p0)) = o2; }
                ssq += __shfl_xor(ssq, 32);
                if (lh == 0) rsq[w * 64 + i] = ssq; }
        }
        __syncthreads();
    }
    if (((NCH - 1) & 1) == par) { const int t2 = opaque_tid(); const int prow = t2 >> 3, c7 = t2 & 7; LAS unsigned char* const raw = raw_;
      bf16_t* dst = MIX + ((size_t)b * SEQ + 64 * (NCH - 2) + prow) * D + 512 + 256 * g;
      SSD_COPY_OUT(dst, raw, prow, c7); }
#undef SSD_COPY_OUT
#undef SSD_FETCH
}
constexpr int CW_QUEUE = 64;
__device__ __forceinline__ void convert_batches(LAS unsigned char* lds, int maxb, unsigned per) {
    const KP p = kparams();
    const int tid = opaque_tid(), lane = tid & 63, wave = __builtin_amdgcn_readfirstlane(tid >> 6);
    LAS float* scr = (LAS float*)(lds + wave * 16384);
    unsigned char* WguT = (unsigned char*)p->out + OUT_WGU; unsigned char* WdT = (unsigned char*)p->out + OUT_WD;
    unsigned* qhead = (unsigned*)(p->ws + WS_CTL) + CW_QUEUE;
    constexpr int I_EXP = 16 * 32, NITEMS = 3 * NE * I_EXP;
    for (int vb = 0; vb != maxb; ++vb) {
        unsigned it0 = 0; if (lane == 0) it0 = __hip_atomic_fetch_add(qhead, per, __ATOMIC_RELAXED, __HIP_MEMORY_SCOPE_AGENT);
        const int r0 = __builtin_amdgcn_readfirstlane((int)it0);
        if (r0 >= NITEMS) break;
        for (int q = 0; q < (int)per; ++q) {
            int r = r0 + q;
            if (r >= NITEMS) break;
            const int which = r / (NE * I_EXP); r %= (NE * I_EXP);
            const int e = r / I_EXP; r %= I_EXP; const int kb = r % 16, nb = r / 16, n0 = 32 * nb;
            if (which == 0) transpose_item_f6(p->in[19] + (size_t)e * D * D, D, 64 * kb, n0, WguT + (size_t)e * 2048 * W8_PITCH, 256 * (n0 >> 7) + 64 * ((n0 & 127) >> 5), scr, lane, W8_SCALE);
            else if (which == 1) transpose_item_f6(p->in[20] + (size_t)e * D * D, D, 64 * kb, n0, WguT + (size_t)e * 2048 * W8_PITCH, 256 * (n0 >> 7) + 64 * ((n0 & 127) >> 5) + 32, scr, lane, W8_SCALE);
            else transpose_item_f6(p->in[23] + (size_t)e * D * D, D, 64 * kb, n0, WdT + (size_t)e * D * W8_PITCH, n0, scr, lane, WD6_SCALE);
        }
    }
}
__device__ __forceinline__ void phase_mixer(LAS unsigned char* lds, int bx, int G) {
    for (int u = bx; u < 192; u += G) {
        if (u < 128) { const int pair = (u & 7) | ((u >> 4) << 3);
            ssd_unit(lds, pair >> 1, pair & 1, (u >> 3) & 1); }
        else gla_unit(lds, (u - 128) >> 1, (u - 128) & 1);
        __syncthreads();
    }
    convert_batches(lds, -1, 8u);
}

__device__ __forceinline__ void phase_ln1_router(LAS unsigned char* lds, int vcu, int G) {
    const KP p = kparams();
    const int tid = opaque_tid(), lane = tid & 63, w = __builtin_amdgcn_readfirstlane(tid >> 6);
    const bf16_t* V1 = (const bf16_t*)(p->ws + WS_V1); unsigned char* H1Q = p->ws + WS_H1Q;
    int* cnt = (int*)(p->ws + WS_CTL); int* tlist = (int*)(p->ws + WS_TLIST); int* tokslot = (int*)(p->ws + WS_TOKSLOT); float* tokgate = (float*)(p->ws + WS_TOKGATE);
    LAS unsigned char* whi = lds; LAS unsigned char* wlo = lds + 33280;
    LAS unsigned char* stg = lds + 66560 + w * 4608;
    LAS float* stat = (LAS float*)(lds + 66560 + 8 * 4608) + w * 64;
    LAS float* gbT = (LAS float*)(lds + 105472);
    LAS int* lcnt = (LAS int*)(lds + 131072);
    LAS int* gbase = lcnt + 32;
    LAS int* rec_e = gbase + 32;
    LAS int* rec_pos = rec_e + 1024;
    LAS float* rec_g = (LAS float*)(rec_pos + 1024);
    const int i = lane & 31, kk = lane >> 5; const unsigned kmask = 0u - (unsigned)kk;
    const float rb = p->in[18][i];
    const float* g1 = p->in[15]; const float* b1 = p->in[16];
    f32x4 gg[4], bb[4];
#pragma unroll
    for (int j = 0; j < 4; ++j) { gg[j] = ((const f32x4*)g1)[2 * lane + (j & 1) + 128 * (j >> 1)]; bb[j] = ((const f32x4*)b1)[2 * lane + (j & 1) + 128 * (j >> 1)]; }
    for (int idx = tid; idx < 1024; idx += NTHREADS) { gbT[idx] = g1[idx]; gbT[1024 + idx] = b1[idx]; }
    for (int blk = vcu; blk < NTOK / 256; blk += G) {
        if (tid < 32) lcnt[tid] = 0;
        const size_t row0 = (size_t)blk * 256 + w * 32;
        u32x4 xn[4][2];
#pragma unroll
        for (int q = 0; q < 4; ++q) { const u32x4* vp = (const u32x4*)(V1 + (row0 + q) * D); xn[q][0] = vp[lane]; xn[q][1] = vp[64 + lane]; }
#pragma unroll 1
        for (int rr = 0; rr < 32; rr += 4) {
            u32x4 xr[4][2];
#pragma unroll
            for (int q = 0; q < 4; ++q) { xr[q][0] = xn[q][0]; xr[q][1] = xn[q][1]; }
            if (rr + 4 < 32) {
#pragma unroll
                for (int q = 0; q < 4; ++q) { const u32x4* vp = (const u32x4*)(V1 + (row0 + rr + 4 + q) * D); xn[q][0] = vp[lane]; xn[q][1] = vp[64 + lane]; } }
#pragma unroll
            for (int q = 0; q < 4; ++q) {
                f32x4 v[4];
#pragma unroll
                for (int c = 0; c < 2; ++c) { const u32x4 x = xr[q][c];
                    v[2 * c] = (f32x4){bf2f(x.x & 0xffffu), bf2f(x.x >> 16), bf2f(x.y & 0xffffu), bf2f(x.y >> 16)}; v[2 * c + 1] = (f32x4){bf2f(x.z & 0xffffu), bf2f(x.z >> 16), bf2f(x.w & 0xffffu), bf2f(x.w >> 16)}; }
                float s = 0.f, s2 = 0.f;
#pragma unroll
                for (int j = 0; j < 4; ++j) { s += (v[j].x + v[j].y) + (v[j].z + v[j].w); s2 += (v[j].x * v[j].x + v[j].y * v[j].y) + (v[j].z * v[j].z + v[j].w * v[j].w); }
                s = wave_sum(s); s2 = wave_sum(s2);
                const float mean = s * (1.f / D), rstd = fast_rsq(fmaxf(s2 * (1.f / D) - mean * mean, 0.f) + LN_EPS);
                if (lane == 0) { stat[2 * (rr + q)] = mean; stat[2 * (rr + q) + 1] = rstd; }
                const size_t row = row0 + rr + q;
                u32x4 o[2];
#pragma unroll
                for (int c = 0; c < 2; ++c) { const f32x4 a = (v[2 * c] - mean) * rstd * gg[2 * c] + bb[2 * c], b = (v[2 * c + 1] - mean) * rstd * gg[2 * c + 1] + bb[2 * c + 1];
                    o[c].x = cvt_pk_bf16(a.x, a.y); o[c].y = cvt_pk_bf16(a.z, a.w); o[c].z = cvt_pk_bf16(b.x, b.y); o[c].w = cvt_pk_bf16(b.z, b.w); }
#pragma unroll
                for (int c = 0; c < 2; ++c) { const u32x4 o2 = o[c] + 0x00800080u; u32x16 blk;
#pragma unroll
                    for (int d = 0; d < 4; ++d) { blk[d] = (unsigned)__builtin_amdgcn_mov_dpp((int)o2[d], 0x00, 0xf, 0xf, false); blk[4 + d] = (unsigned)__builtin_amdgcn_mov_dpp((int)o2[d], 0x55, 0xf, 0xf, false);
                        blk[8 + d] = (unsigned)__builtin_amdgcn_mov_dpp((int)o2[d], 0xaa, 0xf, 0xf, false); blk[12 + d] = (unsigned)__builtin_amdgcn_mov_dpp((int)o2[d], 0xff, 0xf, 0xf, false); }
                    const u32x6 r6 = cvt_fp6x32(blk);
                    const int kb = (lane >> 2) + 16 * c; unsigned char* slot = H1Q + row * D + 128 * (kb >> 2); const int g = kb & 3;
                    if ((lane & 3) == 0) *(u32x4*)(slot + 16 * g) = (u32x4){r6[0], r6[1], r6[2], r6[3]};
                    if ((lane & 3) == 1) *(u32x2*)(slot + 64 + 8 * g) = (u32x2){r6[4], r6[5]}; }
            }
        }
        const float mean = stat[2 * i], rstd = stat[2 * i + 1];
        f32x16 acc;
#pragma unroll
        for (int r = 0; r < 16; ++r) acc[r] = 0.f;
        u32x4 tn[4];
#pragma unroll
        for (int q = 0; q < 4; ++q) tn[q] = *(const u32x4*)(V1 + (row0 + 8 * q + (lane >> 3)) * D + 8 * (lane & 7));
        for (int kh = 0; kh < 2; ++kh) {
            __syncthreads();
            { const u32x4* src = (const u32x4*)(p->ws + WS_RWT + (size_t)kh * 66560);
              for (int idx = tid; idx < 66560 / 16; idx += NTHREADS) ((LAS u32x4*)whi)[idx] = src[idx]; }
            __syncthreads();
#pragma unroll 1
            for (int kc = 0; kc < 8; ++kc) {
                const int k0 = 512 * kh + 64 * kc;
#pragma unroll
                for (int q = 0; q < 4; ++q) { const int r8 = 8 * q + (lane >> 3); *(LAS u32x4*)(stg + 144 * r8 + 16 * (lane & 7)) = tn[q]; }
                if (k0 + 64 < D) {
#pragma unroll
                    for (int q = 0; q < 4; ++q) tn[q] = *(const u32x4*)(V1 + (row0 + 8 * q + (lane >> 3)) * D + k0 + 64 + 8 * (lane & 7)); }
#pragma unroll
                for (int s4 = 0; s4 < 4; ++s4) {
                    const int c8 = 2 * s4 + kk;
                    const u32x4 x = *(const LAS u32x4*)(stg + 144 * i + 16 * c8);
                    const LAS f32x4* gp = (const LAS f32x4*)(gbT + k0 + 8 * c8); const LAS f32x4* bp = (const LAS f32x4*)(gbT + 1024 + k0 + 8 * c8);
                    const f32x4 ga = gp[0], gb = gp[1], ba = bp[0], bb_ = bp[1];
                    float hn[8];
                    hn[0] = (bf2f(x.x & 0xffffu) - mean) * rstd * ga.x + ba.x; hn[1] = (bf2f(x.x >> 16) - mean) * rstd * ga.y + ba.y;
                    hn[2] = (bf2f(x.y & 0xffffu) - mean) * rstd * ga.z + ba.z; hn[3] = (bf2f(x.y >> 16) - mean) * rstd * ga.w + ba.w;
                    hn[4] = (bf2f(x.z & 0xffffu) - mean) * rstd * gb.x + bb_.x; hn[5] = (bf2f(x.z >> 16) - mean) * rstd * gb.y + bb_.y;
                    hn[6] = (bf2f(x.w & 0xffffu) - mean) * rstd * gb.z + bb_.z; hn[7] = (bf2f(x.w >> 16) - mean) * rstd * gb.w + bb_.w;
                    u32x4 ah, al;
#pragma unroll
                    for (int q = 0; q < 4; ++q) { const unsigned hw = cvt_pk_bf16(hn[2 * q], hn[2 * q + 1]); ah[q] = hw;
                        al[q] = cvt_pk_bf16(hn[2 * q] - __uint_as_float(hw << 16), hn[2 * q + 1] - __uint_as_float(hw & 0xffff0000u)); }
                    const int ko = 2 * (64 * kc + 16 * s4 + 8 * kk);
                    const bf16x8 bh = *(const LAS bf16x8*)(whi + 1040 * i + ko), bl = *(const LAS bf16x8*)(wlo + 1040 * i + ko);
                    const bf16x8 ahv = __builtin_bit_cast(bf16x8, ah), alv = __builtin_bit_cast(bf16x8, al);
                    acc = mfma32(ahv, bh, acc); acc = mfma32(ahv, bl, acc); acc = mfma32(alv, bh, acc);
                }
            }
        }
#pragma unroll
        for (int reg = 0; reg < 16; ++reg) {
            float lv = acc[reg] + rb; const int rl = w * 32 + crow(reg, kk);
            float tv[4]; int te[4];
#pragma unroll
            for (int k = 0; k < 4; ++k) {
                float bvv = lv; int bi = i;
#define TK_STEP(OV, OI) do { const float ov = (OV); const int oi = (OI); if (ov > bvv || (ov == bvv && oi < bi)) { bvv = ov; bi = oi; } } while (0)
                TK_STEP(dppx_f<0xB1>(bvv), dppx_i<0xB1>(bi)); TK_STEP(dppx_f<0x4E>(bvv), dppx_i<0x4E>(bi)); TK_STEP(dppx_f<0x141>(bvv), dppx_i<0x141>(bi)); TK_STEP(dppx_f<0x140>(bvv), dppx_i<0x140>(bi));
                TK_STEP(__shfl_xor(bvv, 16), __shfl_xor(bi, 16));
#undef TK_STEP
                tv[k] = bvv; te[k] = bi; if (i == bi) lv = -3.0e38f;
            }
            const float e1 = __expf(tv[1] - tv[0]), e2 = __expf(tv[2] - tv[0]), e3 = __expf(tv[3] - tv[0]); const float inv = 1.f / (1.f + e1 + e2 + e3);
            if (i < 4) { const int ek = i == 0 ? te[0] : (i == 1 ? te[1] : (i == 2 ? te[2] : te[3]));
                const float gk = (i == 0 ? 1.f : (i == 1 ? e1 : (i == 2 ? e2 : e3))) * inv;
                const int pos = atomicAdd((int*)&lcnt[ek], 1);
                rec_e[rl * 4 + i] = ek; rec_pos[rl * 4 + i] = pos; rec_g[rl * 4 + i] = gk; }
        }
        __syncthreads();
        if (tid < 32) gbase[tid] = atomicAdd(&cnt[tid], lcnt[tid]);
        __syncthreads();
        for (int r2 = tid; r2 < 1024; r2 += NTHREADS) { const int e = rec_e[r2], gp = gbase[e] + rec_pos[r2]; const int tok = blk * 256 + (r2 >> 2);
            tlist[e * NTOK + gp] = tok; tokslot[tok * 4 + (r2 & 3)] = (e << 20) | gp; tokgate[tok * 4 + (r2 & 3)] = rec_g[r2]; }
        __syncthreads();
    }
}

__device__ __forceinline__ bool moe_plan(const int* cnt, int pass, int& e0, int& e1, int& ybase0) {
    int tb = 0; for (int e = 0; e < NE; ++e) tb += (cnt[e] + 255) >> 8;
    const int npass = (tb + HID_CAP_BLOCKS - 1) / HID_CAP_BLOCKS, target = (tb + npass - 1) / (npass > 0 ? npass : 1);
    int e = 0, yb = 0;
    for (int ps = 0; e < NE; ++ps) {
        int acc = 0; const int es = e, ybs = yb;
        while (e < NE) { const int nrb = (cnt[e] + 255) >> 8; if (acc > 0 && (acc + nrb > HID_CAP_BLOCKS || acc >= target)) break; acc += nrb; yb += nrb * 256; ++e; }
        if (ps == pass) { e0 = es; e1 = e; ybase0 = ybs; return true; }
    }
    return false;
}
__device__ __forceinline__ void phase_moe_gemm(LAS unsigned char* lds, int G, int c, int pass, bool second) {
    const KP p = kparams();
    const int* cnt = (const int*)(p->ws + WS_CTL);
    (void)pass; const int e0 = 0, e1 = NE, yb0 = 0;
    gm::MoeSched S; S.cnt = cnt; S.e0 = e0; S.e1 = e1; S.G = G; S.c = c; S.ybase0 = yb0; S.second = second; S.npn = second ? 4 : 8; S.reset();
    const bf16_t* WguT = (const bf16_t*)((unsigned char*)p->out + OUT_WGU); const bf16_t* WdT = (const bf16_t*)((unsigned char*)p->out + OUT_WD);
    unsigned char* HID = p->ws + WS_HID; unsigned char* Y = p->ws + WS_Y;
    if (!second) { gm::EpiSwiglu E{HID, p->in[21], p->in[22]};
        gm::gemm_phase<gm::EpiSwiglu, gm::MoeSched, true, true, true>(lds, (const bf16_t*)(p->ws + WS_H1Q), WguT, (size_t)2048 * W8_PITCH, (const int*)(p->ws + WS_TLIST), S, E); }
    else { gm::EpiDown E{Y, p->in[24]};
        gm::gemm_phase<gm::EpiDown, gm::MoeSched, false, true, false, true>(lds, (const bf16_t*)HID, WdT, (size_t)D * W8_PITCH, nullptr, S, E); }
}
__device__ __forceinline__ void phase_combine(LAS unsigned char* lds, int vcu, int G) {
    const KP p = kparams();
    const int tid = opaque_tid(), lane = tid & 63, w = __builtin_amdgcn_readfirstlane(tid >> 6);
    const int* cnt = (const int*)(p->ws + WS_CTL); const int* tokslot = (const int*)(p->ws + WS_TOKSLOT); const float* tokgate = (const float*)(p->ws + WS_TOKGATE);
    const bf16_t* V1 = (const bf16_t*)(p->ws + WS_V1); const unsigned char* Y = p->ws + WS_Y;
    LAS int* ybase = (LAS int*)lds;
    if (tid < 64) { int a = tid < NE ? ((cnt[tid] + 255) >> 8) * 256 : 0; const int own = a;
#pragma unroll
        for (int o = 1; o < 32; o <<= 1) { const int t = __shfl_up(a, o); if (lane >= o) a += t; }
        if (tid < NE) ybase[tid] = a - own; }
    __syncthreads();
    const int gw = vcu * NWAVES + w, NGW = G * NWAVES;
    f32x4 g2[4], b2[4];
#pragma unroll
    for (int j = 0; j < 4; ++j) { g2[j] = ((const f32x4*)p->in[25])[2 * lane + (j & 1) + 128 * (j >> 1)]; b2[j] = ((const f32x4*)p->in[26])[2 * lane + (j & 1) + 128 * (j >> 1)]; }
    f32x4 g1[4], b1[4];
#pragma unroll
    for (int j = 0; j < 4; ++j) { g1[j] = ((const f32x4*)p->in[15])[2 * lane + (j & 1) + 128 * (j >> 1)] * ALPHA; b1[j] = ((const f32x4*)p->in[16])[2 * lane + (j & 1) + 128 * (j >> 1)] * ALPHA; }
    for (int t0 = 2 * gw; t0 < NTOK; t0 += 2 * NGW) {
        u32x4 hr[2][2]; u32x2 yr[2][4][2]; float gk[2][4];
#pragma unroll
        for (int r = 0; r < 2; ++r) { const int t = t0 + r;
            const u32x4* hp = (const u32x4*)(V1 + (size_t)t * D); hr[r][0] = hp[lane]; hr[r][1] = hp[64 + lane];
#pragma unroll
            for (int k = 0; k < 4; ++k) { const int sl = tokslot[t * 4 + k]; gk[r][k] = tokgate[t * 4 + k];
                const u32x2* yp = (const u32x2*)(Y + (size_t)(ybase[sl >> 20] + (sl & 0xfffff)) * D); yr[r][k][0] = yp[lane]; yr[r][k][1] = yp[64 + lane]; } }
#pragma unroll
        for (int r = 0; r < 2; ++r) {
            f32x4 v[4];
#pragma unroll
            for (int c = 0; c < 2; ++c) { const u32x4 x = hr[r][c];
                v[2 * c] = (f32x4){bf2f(x.x & 0xffffu), bf2f(x.x >> 16), bf2f(x.y & 0xffffu), bf2f(x.y >> 16)};
                v[2 * c + 1] = (f32x4){bf2f(x.z & 0xffffu), bf2f(x.z >> 16), bf2f(x.w & 0xffffu), bf2f(x.w >> 16)}; }
            { float s1 = 0.f, q1 = 0.f;
#pragma unroll
              for (int j = 0; j < 4; ++j) { s1 += (v[j].x + v[j].y) + (v[j].z + v[j].w); q1 += (v[j].x * v[j].x + v[j].y * v[j].y) + (v[j].z * v[j].z + v[j].w * v[j].w); }
              s1 = wave_sum(s1); q1 = wave_sum(q1);
              const float mean1 = s1 * (1.f / D), rstd1 = fast_rsq(fmaxf(q1 * (1.f / D) - mean1 * mean1, 0.f) + LN_EPS);
#pragma unroll
              for (int j = 0; j < 4; ++j) v[j] = (v[j] - mean1) * rstd1 * g1[j] + b1[j]; }
#pragma unroll
            for (int k = 0; k < 4; ++k)
#pragma unroll
                for (int c = 0; c < 2; ++c) { const u32x2 x = yr[r][k][c]; const float g = gk[r][k] * (1.0f / Y8_SCALE);
                    const f32x2_t a0 = __builtin_amdgcn_cvt_pk_f32_fp8((int)x.x, false), a1 = __builtin_amdgcn_cvt_pk_f32_fp8((int)x.x, true);
                    const f32x2_t a2 = __builtin_amdgcn_cvt_pk_f32_fp8((int)x.y, false), a3 = __builtin_amdgcn_cvt_pk_f32_fp8((int)x.y, true);
                    v[2 * c] += (f32x4){a0.x, a0.y, a1.x, a1.y} * g;
                    v[2 * c + 1] += (f32x4){a2.x, a2.y, a3.x, a3.y} * g; }
            float s = 0.f, s2 = 0.f;
#pragma unroll
            for (int j = 0; j < 4; ++j) { s += (v[j].x + v[j].y) + (v[j].z + v[j].w); s2 += (v[j].x * v[j].x + v[j].y * v[j].y) + (v[j].z * v[j].z + v[j].w * v[j].w); }
            s = wave_sum(s); s2 = wave_sum(s2);
            const float mean = s * (1.f / D), rstd = fast_rsq(fmaxf(s2 * (1.f / D) - mean * mean, 0.f) + LN_EPS);
#pragma unroll
            for (int j = 0; j < 4; ++j) v[j] = v[j] - mean;
            f32x4* op = (f32x4*)(p->out + (size_t)(t0 + r) * D);
#pragma unroll
            for (int j = 0; j < 4; ++j) op[2 * lane + (j & 1) + 128 * (j >> 1)] = v[j] * rstd * g2[j] + b2[j];
        }
    }
}

#define XB_TMO      128
#define XB_XCNT(j)  (256  + 64 * (j))
#define XB_XSUB(j)  (1280 + 64 * (j))
#define XB_XGEN(j)  (2304 + 64 * (j))
#define XB_TOP      3328
#define XB_TOPGEN   3392
#define XCD_BAR_WORDS 3456
#define XB_SPIN_CAP (1u << 22)
constexpr int CW_BAR = 4096;
__device__ __forceinline__ unsigned xb_ld(unsigned* p)              { return __hip_atomic_load(p, __ATOMIC_RELAXED, __HIP_MEMORY_SCOPE_AGENT); }
__device__ __forceinline__ unsigned xb_add(unsigned* p, unsigned v) { return __hip_atomic_fetch_add(p, v, __ATOMIC_RELAXED, __HIP_MEMORY_SCOPE_AGENT); }
__device__ __forceinline__ unsigned xb_xcc_id() { return (unsigned)__builtin_amdgcn_s_getreg((3 << 11) | 20) & 0xFu; }
#define XB_SPIN(cond, bar) do { unsigned _sp = 0; while (cond) { __builtin_amdgcn_s_sleep(1); \
    if ((++_sp & 255u) == 0u) { if (xb_ld(&(bar)[XB_TMO])) break; if (_sp > XB_SPIN_CAP) { atomicAdd(&(bar)[XB_TMO], 1u); break; } } } } while (0)
struct XcdBarrier { unsigned* bar; unsigned x; volatile LAS unsigned* st; };
__device__ __forceinline__ XcdBarrier xcd_barrier_post(unsigned* bar, volatile LAS unsigned* st) {
    XcdBarrier b; b.bar = bar; b.x = xb_xcc_id(); b.st = st;
    if (threadIdx.x == 0) (void)xb_add(&bar[XB_XCNT(b.x)], 1u);
    return b;
}
__device__ __forceinline__ void xcd_barrier_complete(unsigned* bar, unsigned x, unsigned& nloc, unsigned& nx) {
    const unsigned G = gridDim.x * gridDim.y * gridDim.z;
    unsigned sum, cnt, mine, sp = 0u;
    for (;;) {
        sum = 0u; cnt = 0u; mine = 0u;
#pragma unroll
        for (unsigned j = 0; j < 16; ++j) { const unsigned c = xb_ld(&bar[XB_XCNT(j)]); sum += c; cnt += (c > 0u) ? 1u : 0u; mine = (j == x) ? c : mine; }
        if (sum == G) break;
        __builtin_amdgcn_s_sleep(1);
        if ((++sp & 255u) == 0u) { if (xb_ld(&bar[XB_TMO])) break; if (sp > XB_SPIN_CAP) { atomicAdd(&bar[XB_TMO], 1u); break; } }
    }
    nloc = mine > 0u ? mine : 1u; nx = cnt > 0u ? cnt : 1u;
}
__device__ __forceinline__ void xcd_barrier(const XcdBarrier& b) {
    asm volatile("s_waitcnt vmcnt(0)" ::: "memory");
    __syncthreads();
    if (threadIdx.x == 0) {
        unsigned* bar = b.bar;
        __builtin_amdgcn_s_waitcnt(0);
        unsigned nloc = b.st[0], nx = b.st[1];
        if (nloc == 0u) { xcd_barrier_complete(bar, b.x, nloc, nx); b.st[0] = nloc; b.st[1] = nx; }
        const unsigned old = xb_add(&bar[XB_XSUB(b.x)], 1u);
        const unsigned gen = old / nloc;
        if (old + 1u == (gen + 1u) * nloc) {
            __builtin_amdgcn_fence(__ATOMIC_RELEASE, "agent");
            asm volatile("s_waitcnt vmcnt(0)" ::: "memory");
            const unsigned og = xb_add(&bar[XB_TOP], 1u);
            const unsigned tg = og / nx;
            if (og + 1u == (tg + 1u) * nx) xb_add(&bar[XB_TOPGEN], 1u);
            else XB_SPIN(xb_ld(&bar[XB_TOPGEN]) == tg, bar);
            __builtin_amdgcn_fence(__ATOMIC_ACQUIRE, "agent");
            xb_add(&bar[XB_XGEN(b.x)], 1u);
            asm volatile("s_waitcnt vmcnt(0)" ::: "memory");
        } else {
            XB_SPIN(xb_ld(&bar[XB_XGEN(b.x)]) == gen, bar);
            __builtin_amdgcn_fence(__ATOMIC_ACQUIRE, "agent");
            asm volatile("s_waitcnt vmcnt(0)" ::: "memory");
        }
    }
    __syncthreads();
}

constexpr int LDS_BARST = LDS_BYTES - 64;
constexpr int NPT = 12;
__device__ __forceinline__ void phase_inproj(LAS unsigned char* lds, int G, int bx) {
    const KP p = kparams();
    gm::StaticSched S; S.init(HROWS / 256, NPT, G, bx); gm::EpiProj E{(bf16_t*)(p->ws + WS_PROJ)};
    gm::gemm_phase<gm::EpiProj, gm::StaticSched, false, false>(lds, (const bf16_t*)(p->ws + WS_H), (const bf16_t*)(p->ws + WS_WIN), 0, nullptr, S, E);
    constexpr int NUN = (HROWS / 256) * NPT;
    if (NUN % G != 0 && bx >= NUN % G) { __syncthreads(); convert_batches(lds, 1, 8u); }
}
__device__ __forceinline__ void phase_outproj(LAS unsigned char* lds, int G, int bx) {
    const KP p = kparams();
    gm::StaticSched S; S.init(NTOK / 256, D / 256, G, bx); gm::EpiOut E{(const bf16_t*)(p->ws + WS_H), (bf16_t*)(p->ws + WS_V1)};
    gm::gemm_phase<gm::EpiOut, gm::StaticSched, false, false>(lds, (const bf16_t*)(p->ws + WS_MIX), (const bf16_t*)(p->ws + WS_WOUT), 0, nullptr, S, E);
}
__global__ void __launch_bounds__(NTHREADS, 2) mk_fwd(Params p_args) {
    (void)p_args;
    extern __shared__ __attribute__((aligned(16))) unsigned char lds_raw[];
    LAS unsigned char* lds = (LAS unsigned char*)lds_raw;
    const int G = gridDim.x, bx = blockIdx.x;
    const int vcu = (G % 8 == 0) ? (bx % 8) * (G / 8) + bx / 8 : bx;
    volatile LAS unsigned* barst = (volatile LAS unsigned*)(lds + LDS_BARST);
    if (threadIdx.x < 16) barst[threadIdx.x] = 0u;
    __syncthreads();
    const XcdBarrier bar = xcd_barrier_post((unsigned*)(kparams()->ws + WS_CTL) + CW_BAR, barst);

#ifndef PROBE_DUP
#define PROBE_DUP -1
#endif
    for (int rep = 0; rep < (PROBE_DUP == 0 ? 2 : 1); ++rep) { phase_prep(lds, vcu, G); xcd_barrier(bar); }
    for (int rep = 0; rep < (PROBE_DUP == 1 ? 2 : 1); ++rep) { phase_inproj(lds, G, bx); xcd_barrier(bar); }
    for (int rep = 0; rep < (PROBE_DUP == 8 ? 2 : 1); ++rep) { phase_pre(lds, vcu, G); xcd_barrier(bar); }
    for (int rep = 0; rep < (PROBE_DUP == 2 ? 2 : 1); ++rep) { phase_mixer(lds, bx, G); xcd_barrier(bar); }
    for (int rep = 0; rep < (PROBE_DUP == 3 ? 2 : 1); ++rep) { phase_outproj(lds, G, bx); xcd_barrier(bar); }
    phase_ln1_router(lds, vcu, G);
    xcd_barrier(bar);
    for (int rep = 0; rep < (PROBE_DUP == 5 ? 2 : 1); ++rep) { phase_moe_gemm(lds, G, bx, 0, false); xcd_barrier(bar); }
    for (int rep = 0; rep < (PROBE_DUP == 6 ? 2 : 1); ++rep) { phase_moe_gemm(lds, G, bx, 0, true); xcd_barrier(bar); }
    for (int rep = 0; rep < (PROBE_DUP == 7 ? 2 : 1); ++rep) { phase_combine(lds, vcu, G); if (PROBE_DUP == 7) xcd_barrier(bar); }
}

extern "C" void kernel_launch(void* const* d_in, const int* in_sizes, int n_in, void* d_out, int out_size, void* d_ws, size_t ws_size, hipStream_t stream) {
    (void)in_sizes; (void)out_size;
    static int grid = 0;
    if (grid == 0) {
        if (n_in != 27 || ws_size < 1024 * MiB) { fprintf(stderr, "kernel_launch: unexpected n_in %d or ws_size %zu\n", n_in, ws_size); grid = -1; return; }
        int dev = 0, cus = 0, per_cu = 0;
        if (hipGetDevice(&dev) != hipSuccess || hipDeviceGetAttribute(&cus, hipDeviceAttributeMultiprocessorCount, dev) != hipSuccess) { grid = -1; return; }
        if (hipFuncSetAttribute((const void*)mk_fwd, hipFuncAttributeMaxDynamicSharedMemorySize, LDS_BYTES) != hipSuccess) { fprintf(stderr, "kernel_launch: hipFuncSetAttribute failed\n"); grid = -1; return; }
        if (hipOccupancyMaxActiveBlocksPerMultiprocessor(&per_cu, (const void*)mk_fwd, NTHREADS, LDS_BYTES) != hipSuccess || per_cu < 1) { fprintf(stderr, "kernel_launch: occupancy query says %d blocks per CU\n", per_cu); per_cu = 1; }
        (void)hipGetLastError();
        grid = cus;
        if (grid > 256) grid = 256;
    }
    if (grid < 0) return;
    Params p{};
    for (int i = 0; i < 27; ++i) p.in[i] = (const float*)d_in[i];
    p.out = (float*)d_out; p.ws = (unsigned char*)d_ws; p.pass = 0; p.pad = 0;
    (void)hipMemsetAsync((char*)d_ws + WS_CTL, 0, CTL_BYTES, stream);
    hipLaunchKernelGGL(mk_fwd, dim3(grid), dim3(NTHREADS), LDS_BYTES, stream, p);
}
```
